# Optimizing an MI355X kernel written in HIP

```python
import math, functools
import jax, jax.numpy as jnp
from jax import lax
import numpy as np

D_MODEL = 1024
BATCH = 16
SEQ = 2048
DEPTH = 2
DEC_BATCH = 8
DEC_SEQ = 16
PAST_LEN = 2048

CHUNK = 64
Q_BLOCK = 128
N_MIXERS = 2
H_A = 8
DH_A = 64
DV_A = 2 * DH_A
D_A = H_A * DV_A
H_B = 16
DH_B = 64
D_B = H_B * DH_B
RMS_EPS = 1e-6

kernel_name = 'streaming_diff_stickbreak_hybrid_step'


def rms_norm(x, g):
    x32 = x.astype(jnp.float32)
    y = x32 * lax.rsqrt(jnp.mean(x32 * x32, axis=-1, keepdims=True) + RMS_EPS)
    return (y * g.astype(jnp.float32)).astype(x.dtype)


def alibi_slopes(n_heads):
    return 2.0 ** (-8.0 * jnp.arange(1, n_heads + 1, dtype=jnp.float32) / n_heads)


def diff_lambda_init(layer):
    return 0.8 - 0.6 * math.exp(-0.3 * layer)


def diff_core(q, k, v, q_pos, k_pos, lam, slopes):
    s = jnp.einsum('bqhcd,bkhcd->bchqk', q.astype(jnp.float32), k.astype(jnp.float32)) * (DH_A ** -0.5)
    dist = jnp.abs(q_pos[:, None] - k_pos[None, :]).astype(jnp.float32)
    visible = (k_pos[None, :] // CHUNK) <= (q_pos[:, None] // CHUNK)
    s = jnp.where(visible, s - slopes[:, None, None] * dist, -jnp.inf)
    p = jax.nn.softmax(s, axis=-1)
    a = p[:, 0] - lam * p[:, 1]
    return jnp.einsum('bhqk,bkhe->bqhe', a, v.astype(jnp.float32))


def stick_breaking_core(q, k, v, q_pos, k_pos):
    z = jnp.einsum('bqhd,bkhd->bhqk', q.astype(jnp.float32), k.astype(jnp.float32)) * (DH_B ** -0.5)
    before = k_pos[None, :] < q_pos[:, None]
    log_beta = jax.nn.log_sigmoid(z)
    log_keep = jnp.where(before, log_beta - z, 0.0)
    log_keep_after = lax.cumsum(log_keep, axis=3, reverse=True) - log_keep
    a = jnp.where(before, jnp.exp(log_beta + log_keep_after), 0.0)
    return jnp.einsum('bhqk,bkhd->bqhd', a, v.astype(jnp.float32))


def sweep_query_blocks(core, q, k, v):
    seq = q.shape[1]
    outs = []
    for i in range(seq // Q_BLOCK):
        lo, hi = i * Q_BLOCK, (i + 1) * Q_BLOCK
        outs.append(core(q[:, lo:hi], k[:, :hi], v[:, :hi], jnp.arange(lo, hi), jnp.arange(hi)))
    return jnp.concatenate(outs, axis=1)


def diff_layer(x, norm_g, w_in, q_norm, k_norm, lambda_q1, lambda_k1, lambda_q2, lambda_k2,
               subln_g, w_out, layer, past_k=None, past_v=None):
    b, s, _ = x.shape
    h = rms_norm(x, norm_g)
    q, k, v, gate = jnp.split(h @ w_in, [D_A, 2 * D_A, 3 * D_A], axis=-1)
    q = rms_norm(q.reshape(b, s, H_A, 2, DH_A), q_norm)
    k = rms_norm(k.reshape(b, s, H_A, 2, DH_A), k_norm)
    v = v.reshape(b, s, H_A, DV_A)
    lam_init = diff_lambda_init(layer)
    f32 = jnp.float32
    lam = (jnp.exp(jnp.sum(lambda_q1.astype(f32) * lambda_k1.astype(f32)))
           - jnp.exp(jnp.sum(lambda_q2.astype(f32) * lambda_k2.astype(f32))) + lam_init)
    core = functools.partial(diff_core, lam=lam, slopes=alibi_slopes(H_A))
    if past_k is None:
        o = sweep_query_blocks(core, q, k, v)
    else:
        p_len = past_k.shape[1]
        k_all = jnp.concatenate([past_k.reshape(b, p_len, H_A, 2, DH_A), k], axis=1)
        v_all = jnp.concatenate([past_v, v], axis=1)
        o = core(q, k_all, v_all, p_len + jnp.arange(s), jnp.arange(p_len + s))
    o = rms_norm(o, subln_g) * (1.0 - lam_init)
    y = (o.reshape(b, s, D_A).astype(x.dtype) * jax.nn.silu(gate)) @ w_out
    return x + y, k.reshape(b, s, H_A, 2 * DH_A), v


def stick_breaking_layer(x, norm_g, w_in, w_out, past_k=None, past_v=None):
    b, s, _ = x.shape
    h = rms_norm(x, norm_g)
    q, k, v, gate = jnp.split(h @ w_in, [D_B, 2 * D_B, 3 * D_B], axis=-1)
    q = q.reshape(b, s, H_B, DH_B)
    k = k.reshape(b, s, H_B, DH_B)
    v = v.reshape(b, s, H_B, DH_B)
    if past_k is None:
        o = sweep_query_blocks(stick_breaking_core, q, k, v)
    else:
        p_len = past_k.shape[1]
        k_all = jnp.concatenate([past_k, k], axis=1)
        v_all = jnp.concatenate([past_v, v], axis=1)
        o = stick_breaking_core(q, k_all, v_all, p_len + jnp.arange(s), jnp.arange(p_len + s))
    y = (o.reshape(b, s, D_B).astype(x.dtype) * jax.nn.silu(gate)) @ w_out
    return x + y, k, v


def setup_inputs(seed: int = 0) -> dict:
    key = jax.random.key(seed)
    ks = jax.random.split(key, 20)
    f32 = jnp.float32
    nrm = lambda k, shape, scale: scale * jax.random.normal(k, shape, f32)
    return {
        'x_prompt': nrm(ks[0], (BATCH, SEQ, D_MODEL), 1.0),
        'x_sample': nrm(ks[1], (DEC_BATCH, DEC_SEQ, D_MODEL), 1.0),
        'cache_k_0': nrm(ks[2], (DEC_BATCH, PAST_LEN, H_A, 2 * DH_A), 1.0),
        'cache_v_0': nrm(ks[3], (DEC_BATCH, PAST_LEN, H_A, DV_A), 1.0),
        'cache_k_1': nrm(ks[4], (DEC_BATCH, PAST_LEN, H_B, DH_B), 1.0),
        'cache_v_1': nrm(ks[5], (DEC_BATCH, PAST_LEN, H_B, DH_B), 1.0),
        'norm_g_0': 1.0 + nrm(ks[6], (D_MODEL,), 0.02),
        'w_in_0': nrm(ks[7], (D_MODEL, 4 * D_A), D_MODEL ** -0.5),
        'q_norm_0': 1.0 + nrm(ks[8], (DH_A,), 0.02),
        'k_norm_0': 1.0 + nrm(ks[9], (DH_A,), 0.02),
        'lambda_q1_0': nrm(ks[10], (DH_A,), 0.1),
        'lambda_k1_0': nrm(ks[11], (DH_A,), 0.1),
        'lambda_q2_0': nrm(ks[12], (DH_A,), 0.1),
        'lambda_k2_0': nrm(ks[13], (DH_A,), 0.1),
        'subln_g_0': 1.0 + nrm(ks[14], (DV_A,), 0.02),
        'w_out_0': nrm(ks[15], (D_A, D_MODEL), D_A ** -0.5),
        'norm_g_1': 1.0 + nrm(ks[16], (D_MODEL,), 0.02),
        'w_in_1': nrm(ks[17], (D_MODEL, 4 * D_B), D_MODEL ** -0.5),
        'w_out_1': nrm(ks[18], (D_B, D_MODEL), D_B ** -0.5),
    }


def reference(x_prompt, x_sample, cache_k_0, cache_v_0, cache_k_1, cache_v_1,
              norm_g_0, w_in_0, q_norm_0, k_norm_0, lambda_q1_0, lambda_k1_0,
              lambda_q2_0, lambda_k2_0, subln_g_0, w_out_0,
              norm_g_1, w_in_1, w_out_1):
    diff_params = (norm_g_0, w_in_0, q_norm_0, k_norm_0, lambda_q1_0, lambda_k1_0,
                   lambda_q2_0, lambda_k2_0, subln_g_0, w_out_0)
    sb_params = (norm_g_1, w_in_1, w_out_1)
    layer_inputs = ((diff_params, cache_k_0, cache_v_0), (sb_params, cache_k_1, cache_v_1))
    y_prompt, y_sample = x_prompt, x_sample
    new_state = []
    for layer in range(DEPTH):
        params, ck, cv = layer_inputs[layer]
        if layer % N_MIXERS == 0:
            y_prompt, kp, vp = diff_layer(y_prompt, *params, layer=layer)
            y_sample, ks, vs = diff_layer(y_sample, *params, layer=layer, past_k=ck, past_v=cv)
        else:
            y_prompt, kp, vp = stick_breaking_layer(y_prompt, *params)
            y_sample, ks, vs = stick_breaking_layer(y_sample, *params, past_k=ck, past_v=cv)
        new_state.append((kp, vp, ks, vs))
    (k0_prompt, v0_prompt, k0_sample, v0_sample), (k1_prompt, v1_prompt, k1_sample, v1_sample) = new_state
    return (y_prompt, y_sample, k0_prompt, v0_prompt, k0_sample, v0_sample,
            k1_prompt, v1_prompt, k1_sample, v1_sample)
```

```cpp
#include <hip/hip_runtime.h>
#include <hip/hip_cooperative_groups.h>
#include <cstdio>
namespace cg = cooperative_groups;

typedef __attribute__((ext_vector_type(8))) short bf16x8;
typedef __attribute__((ext_vector_type(4))) float f32x4;
typedef __attribute__((ext_vector_type(16))) float f32x16;
typedef __attribute__((ext_vector_type(2))) __bf16 bf2_t;
typedef unsigned short u16;

#define DEV __device__ __forceinline__

constexpr int NTOK_P = 32768;
constexpr int NTOK = 32896;
constexpr size_t NP = 33554432, NS = 131072;
constexpr size_t OFF_K0P = NP + NS, OFF_V0P = 2 * NP + NS, OFF_K0S = 3 * NP + NS, OFF_V0S = 3 * NP + 2 * NS;
constexpr size_t OFF_K1P = 3 * NP + 3 * NS, OFF_V1P = 4 * NP + 3 * NS, OFF_K1S = 5 * NP + 3 * NS, OFF_V1S = 5 * NP + 4 * NS;

constexpr size_t WS_WT_IN0 = 0;
constexpr size_t WS_WT_OUT0 = 8388608;
constexpr size_t WS_WT_IN1 = 10485760;
constexpr size_t WS_WT_OUT1 = 18874368;
constexpr size_t WS_ACT = 20971520;
constexpr size_t WS_SG = WS_ACT + 67371008;
constexpr size_t WS_QF = WS_SG + 67371008;
constexpr size_t WS_KF = WS_QF + 67108864;
constexpr size_t WS_VF = WS_KF + 67108864;
constexpr size_t WS_QFS = WS_VF + 67108864;
constexpr size_t WS_KFS = WS_QFS + 524288;
constexpr size_t WS_VFS = WS_KFS + 524288;
constexpr size_t WS_CNT = WS_VFS + 524288;
constexpr size_t WS_BAR = WS_CNT + 256;
constexpr int LDS_BYTES = 131072 + 18432;
constexpr float LOG2E = 1.4426950408889634f;

struct Params {
  const float* x_prompt; const float* x_sample;
  const float* ck0; const float* cv0; const float* ck1; const float* cv1;
  const float* norm_g0; const float* w_in0; const float* q_norm; const float* k_norm;
  const float* lq1; const float* lk1; const float* lq2; const float* lk2;
  const float* subln_g; const float* w_out0; const float* norm_g1; const float* w_in1; const float* w_out1;
  float* out;
  char* ws;
};

DEV unsigned pk2(float a, float b) { bf2_t v; v[0] = (__bf16)a; v[1] = (__bf16)b; return __builtin_bit_cast(unsigned, v); }
DEV u16 f2bf(float a) { __bf16 v = (__bf16)a; return __builtin_bit_cast(u16, v); }
DEV float bflo(unsigned v) { return __uint_as_float(v << 16); }
DEV float bfhi(unsigned v) { return __uint_as_float(v & 0xffff0000u); }
DEV bf16x8 mk8(unsigned a, unsigned b, unsigned c, unsigned d) { uint4 q = make_uint4(a, b, c, d); return __builtin_bit_cast(bf16x8, q); }
DEV float wave_sum(float v) {
#pragma unroll
  for (int o = 32; o; o >>= 1) v += __shfl_xor(v, o);
  return v;
}
DEV int opaque_tid() { int t = threadIdx.x; asm volatile("" : "+v"(t)); return t; }
DEV float ex2(float x) { return __builtin_amdgcn_exp2f(x); }
DEV float lg2(float x) { return __builtin_amdgcn_logf(x); }

typedef __attribute__((ext_vector_type(4))) unsigned u32x4_t;
DEV void nt_store_u4(void* ptr, uint4 v) { u32x4_t q = {v.x, v.y, v.z, v.w}; __builtin_nontemporal_store(q, (u32x4_t*)ptr); }
DEV void nt_store_f4(void* ptr, f32x4 v) { __builtin_nontemporal_store(v, (f32x4*)ptr); }

namespace pg8 {
#define PG8_LAS __attribute__((address_space(3)))
constexpr int BM = 256, BK = 64, HALF = 128, HTB = HALF * BK * 2, STAGE_BYTES = 8 * HTB, NXCD = 8, WGM = 8;
__device__ __forceinline__ int lds_byte(int r, int c) { const int st = (r >> 4) * 2 + (c >> 5), rr = r & 15, cc = c & 31, ob = rr * 64 + cc * 2; return st * 1024 + (ob ^ (((ob >> 9) & 1) << 5)); }
__device__ __forceinline__ void stage_rc(int b, int& R, int& C) { const int st = b / 1024, sb = b % 1024, swz = sb ^ (((sb >> 9) & 1) << 5); R = (st >> 1) * 16 + swz / 64; C = (st & 1) * 32 + (swz % 64) / 2; }
struct Unit { int pm, pn; };
struct Gemm { const u16* A; const u16* Bt; int M, N, K; };
struct StaticOrder {
  int nM, nN, nwg, G, c;
  __device__ void init(int M, int N, int G_, int c_) { nM = M / BM; nN = N / BM; nwg = nM * nN; G = G_; c = c_; }
  __device__ bool next(int i, Unit& u) const {
    const long L = (long)i * G + c; if (L >= nwg) return false;
    int wgid = (int)L; { const int q = nwg / NXCD, r = nwg % NXCD, xcd = wgid % NXCD, off = wgid / NXCD; wgid = (xcd < r ? xcd * (q + 1) : r * (q + 1) + (xcd - r) * q) + off; }
    const int nig = WGM * nN, gid = wgid / nig, fm = gid * WGM, gsz = (nM - fm) < WGM ? (nM - fm) : WGM;
    u.pm = fm + ((wgid % nig) % gsz); u.pn = (wgid % nig) / gsz; return true;
  }
};
template <class Epi>
__device__ __forceinline__ void gemm_phase(PG8_LAS unsigned char* lds, const Gemm g, const StaticOrder& S, const Epi& E) {
  const int tid = opaque_tid(), wid = __builtin_amdgcn_readfirstlane(tid >> 6), lane = tid & 63, wr = wid >> 2, wc = wid & 3, fr = lane & 15, fq = lane >> 4;
  const int K = g.K, nt = K / BK;
  unsigned voffA[2], voffB[2];
#pragma unroll
  for (int i = 0; i < 2; ++i) { int R, C; stage_rc(tid * 16 + i * 8192, R, C); const int Rb = ((R >> 5) << 6) + (R & 31);
    voffA[i] = (unsigned)(R * K + C) * 2u; voffB[i] = (unsigned)(Rb * K + C) * 2u; }
  const size_t kstep = (size_t)(BK * 2);
  const size_t hstep = (size_t)HALF * K * 2;
  const size_t hstepB = (size_t)32 * K * 2;
  const size_t tstep = 2 * hstep;
  const unsigned ldsw = (unsigned)wid * 1024u;
  const int aoff = lds_byte(wr * 64 + fr, fq * 8), boff = lds_byte(wc * 32 + fr, fq * 8);
#define PG8_SA(b, h) (((b) * 2 + (h)) * HTB)
#define PG8_SB(b, h) ((4 + (b) * 2 + (h)) * HTB)
#define PG8_STAGE(bufoff, gbase, voff) do { _Pragma("unroll") for (int _i = 0; _i < 2; ++_i) \
    __builtin_amdgcn_global_load_lds((const __attribute__((address_space(1))) unsigned*)((const char*)(gbase) + (voff)[_i]), (PG8_LAS unsigned*)(lds + (bufoff) + ldsw + _i * 8192), 16, 0, 0); } while (0)
#define PG8_LDA(dst, b, h) do { _Pragma("unroll") for (int m = 0; m < 4; ++m) _Pragma("unroll") for (int k = 0; k < 2; ++k) dst[m][k] = *(const PG8_LAS bf16x8*)(lds + PG8_SA(b, h) + aoff + m * 2048 + k * 1024); } while (0)
#define PG8_LDB(dst, b, h) do { _Pragma("unroll") for (int n = 0; n < 2; ++n) _Pragma("unroll") for (int k = 0; k < 2; ++k) dst[n][k] = *(const PG8_LAS bf16x8*)(lds + PG8_SB(b, h) + boff + n * 2048 + k * 1024); } while (0)
#define PG8_MMA(ai, bj, At, Bt) do { __builtin_amdgcn_s_setprio(1); _Pragma("unroll") for (int m = 0; m < 4; ++m) _Pragma("unroll") for (int n = 0; n < 2; ++n) _Pragma("unroll") for (int k = 0; k < 2; ++k) \
    acc[ai][bj][m][n] = __builtin_amdgcn_mfma_f32_16x16x32_bf16(Bt[n][k], At[m][k], acc[ai][bj][m][n], 0, 0, 0); __builtin_amdgcn_s_setprio(0); } while (0)
#define PG8_WAIT_V(n) asm volatile("s_waitcnt vmcnt(" #n ")" ::: "memory")
#define PG8_WAIT_L(n) asm volatile("s_waitcnt lgkmcnt(" #n ")" ::: "memory")
#define PG8_BAR __builtin_amdgcn_s_barrier()
#define PG8_SCHED __builtin_amdgcn_sched_barrier(0)
  Unit cur, nxt; int ui = 0;
  if (!S.next(0, cur)) return;
  f32x4 acc[2][2][4][2];
#pragma unroll
  for (int a = 0; a < 2; ++a)
#pragma unroll
    for (int b = 0; b < 2; ++b)
#pragma unroll
      for (int m = 0; m < 4; ++m)
#pragma unroll
        for (int n = 0; n < 2; ++n) acc[a][b][m][n] = (f32x4){0.f, 0.f, 0.f, 0.f};
  bf16x8 At[4][2], B0[2][2], B1[2][2];
  const char* cA = (const char*)g.A + (size_t)cur.pm * tstep; const char* cB = (const char*)g.Bt + (size_t)cur.pn * tstep;
  PG8_STAGE(PG8_SB(0, 0), cB, voffB); PG8_STAGE(PG8_SA(0, 0), cA, voffA); PG8_STAGE(PG8_SB(0, 1), cB + hstepB, voffB); PG8_STAGE(PG8_SA(0, 1), cA + hstep, voffA);
  if (wr == 1) PG8_BAR;
  PG8_WAIT_V(4); PG8_BAR;
  PG8_STAGE(PG8_SB(1, 0), cB + kstep, voffB); PG8_STAGE(PG8_SA(1, 0), cA + kstep, voffA); PG8_STAGE(PG8_SB(1, 1), cB + hstepB + kstep, voffB);
  PG8_WAIT_V(6); PG8_BAR;
  for (;;) {
    const bool has_next = S.next(ui + 1, nxt);
    const char* nA = has_next ? (const char*)g.A + (size_t)nxt.pm * tstep : cA; const char* nB = has_next ? (const char*)g.Bt + (size_t)nxt.pn * tstep : cB;
    for (int t = 0; t < nt; t += 2) {
      const bool last = (t == nt - 2);
      const char* a1 = cA + (size_t)(t + 1) * kstep;
      const char* a2 = last ? nA : cA + (size_t)(t + 2) * kstep; const char* b2 = last ? nB : cB + (size_t)(t + 2) * kstep;
      const char* a3 = a2 + kstep; const char* b3 = b2 + kstep;
      PG8_LDB(B0, 0, 0); PG8_SCHED; PG8_LDA(At, 0, 0); PG8_STAGE(PG8_SA(1, 1), a1 + hstep, voffA);
      PG8_WAIT_L(8); PG8_BAR; PG8_WAIT_L(0); PG8_MMA(0, 0, At, B0); PG8_BAR; PG8_SCHED;
      PG8_LDB(B1, 0, 1); PG8_STAGE(PG8_SB(0, 0), b2, voffB);
      PG8_BAR; PG8_WAIT_L(0); PG8_MMA(0, 1, At, B1); PG8_BAR;
      PG8_LDA(At, 0, 1); PG8_STAGE(PG8_SA(0, 0), a2, voffA);
      PG8_BAR; PG8_WAIT_L(0); PG8_MMA(1, 0, At, B0); PG8_BAR; PG8_SCHED;
      PG8_STAGE(PG8_SB(0, 1), b2 + hstepB, voffB);
      PG8_WAIT_V(6); PG8_BAR; PG8_MMA(1, 1, At, B1); PG8_BAR;
      PG8_LDB(B0, 1, 0); PG8_SCHED; PG8_LDA(At, 1, 0); PG8_STAGE(PG8_SA(0, 1), a2 + hstep, voffA);
      PG8_WAIT_L(8); PG8_BAR; PG8_WAIT_L(0); PG8_MMA(0, 0, At, B0); PG8_BAR; PG8_SCHED;
      PG8_LDB(B1, 1, 1); PG8_STAGE(PG8_SB(1, 0), b3, voffB);
      PG8_BAR; PG8_WAIT_L(0); PG8_MMA(0, 1, At, B1); PG8_BAR;
      PG8_LDA(At, 1, 1); PG8_STAGE(PG8_SA(1, 0), a3, voffA);
      PG8_BAR; PG8_WAIT_L(0); PG8_MMA(1, 0, At, B0); PG8_BAR; PG8_SCHED;
      PG8_STAGE(PG8_SB(1, 1), b3 + hstepB, voffB);
      PG8_WAIT_V(6); PG8_BAR; PG8_MMA(1, 1, At, B1); PG8_BAR;
    }
    E(acc, cur, wr, wc, fr, fq);
    if (!has_next) break;
#pragma unroll
    for (int a = 0; a < 2; ++a)
#pragma unroll
      for (int b = 0; b < 2; ++b)
#pragma unroll
        for (int m = 0; m < 4; ++m)
#pragma unroll
          for (int n = 0; n < 2; ++n) acc[a][b][m][n] = (f32x4){0.f, 0.f, 0.f, 0.f};
    cur = nxt; cA = nA; cB = nB; ++ui;
  }
  PG8_WAIT_V(0);
  if (wr == 0) PG8_BAR;
  PG8_BAR;
#undef PG8_SA
#undef PG8_SB
#undef PG8_STAGE
#undef PG8_LDA
#undef PG8_LDB
#undef PG8_MMA
#undef PG8_WAIT_V
#undef PG8_WAIT_L
#undef PG8_BAR
#undef PG8_SCHED
}
}

template <int LAYER>
struct EpiIn {
  Params p; char* xl;
  DEV void operator()(const f32x4 (&acc)[2][2][4][2], const pg8::Unit& u, int wr, int wc, int fr, int fq) const {
    const int lane = fq * 16 + fr;
    const int nb = u.pn * 256 + wc * 64;
    const int region = nb >> 10, f0 = nb & 1023, hc = f0 >> 6;
    char* ws = p.ws;
    u16* vl = (u16*)(xl + (wr * 4 + wc) * 2304);
#pragma unroll
    for (int ai = 0; ai < 2; ++ai) {
      const int tb = u.pm * 256 + ai * 128 + wr * 64;
      if (region <= 1) {
        const float* gn = (region == 0) ? p.q_norm : p.k_norm;
#pragma unroll
        for (int m = 0; m < 4; ++m) {
          const int t = tb + m * 16 + fr;
          const int b = t >> 11, s = t & 2047;
          float rinv = 1.f;
          if (LAYER == 0) {
            float ss = 0.f;
#pragma unroll
            for (int bj = 0; bj < 2; ++bj)
#pragma unroll
              for (int n = 0; n < 2; ++n)
#pragma unroll
                for (int j = 0; j < 4; ++j) ss += acc[ai][bj][m][n][j] * acc[ai][bj][m][n][j];
            ss += __shfl_xor(ss, 16);
            ss += __shfl_xor(ss, 32);
            rinv = rsqrtf(ss * (1.f / 64.f) + 1e-6f);
          }
          u16* fb = (u16*)(ws + (region == 0 ? WS_QF : WS_KF)) + ((size_t)(b * 16 + hc) * 64 + (s >> 5)) * 2048 + ((fq >> 1) * 32 + (s & 31)) * 8 + (fq & 1) * 4;
          float* ko = p.out + (LAYER == 0 ? OFF_K0P : OFF_K1P) + (size_t)t * 1024 + f0 + 4 * fq;
#pragma unroll
          for (int bj = 0; bj < 2; ++bj)
#pragma unroll
            for (int n = 0; n < 2; ++n) {
              f32x4 v = acc[ai][bj][m][n];
              if (LAYER == 0) {
                const f32x4 g4 = *(const f32x4*)(gn + 32 * bj + 16 * n + 4 * fq);
                v = v * g4 * rinv;
              }
              if (region == 1) nt_store_f4(ko + 32 * bj + 16 * n, v);
              if (region == 0) v = v * (0.125f * LOG2E);
              uint2 pk;
              pk.x = pk2(v[0], v[1]);
              pk.y = pk2(v[2], v[3]);
              *(uint2*)(fb + (2 * bj + n) * 512) = pk;
            }
        }
      } else if (region == 2) {
#pragma unroll
        for (int m = 0; m < 4; ++m) {
          float* vo = p.out + (LAYER == 0 ? OFF_V0P : OFF_V1P) + (size_t)(tb + m * 16 + fr) * 1024 + f0 + 4 * fq;
#pragma unroll
          for (int bj = 0; bj < 2; ++bj)
#pragma unroll
            for (int n = 0; n < 2; ++n) nt_store_f4(vo + 32 * bj + 16 * n, acc[ai][bj][m][n]);
        }
        const int r = lane & 31, hh = lane >> 5;
#pragma unroll
        for (int mp = 0; mp < 2; ++mp) {
          const int tk = tb + mp * 32;
          const int b = tk >> 11, tile = (tk & 2047) >> 5;
#pragma unroll
          for (int bj = 0; bj < 2; ++bj) {
#pragma unroll
            for (int mm = 0; mm < 2; ++mm)
#pragma unroll
              for (int n = 0; n < 2; ++n)
#pragma unroll
                for (int j = 0; j < 4; ++j) vl[(16 * n + 4 * fq + j) * 36 + mm * 16 + fr] = f2bf(acc[ai][bj][2 * mp + mm][n][j]);
            u16* vb;
            if (LAYER == 0) vb = (u16*)(ws + WS_VF) + ((size_t)(b * 8 + (f0 >> 7)) * 64 + tile) * 4096 + ((((f0 & 127) >> 5) + bj) * 2) * 512 + lane * 8;
            else            vb = (u16*)(ws + WS_VF) + ((size_t)(b * 16 + hc) * 64 + tile) * 2048 + (bj * 2) * 512 + lane * 8;
#pragma unroll
            for (int sv = 0; sv < 2; ++sv) {
              const uint2 lo = *(const uint2*)(vl + r * 36 + 16 * sv + 4 * hh);
              const uint2 hi = *(const uint2*)(vl + r * 36 + 16 * sv + 8 + 4 * hh);
              *(uint4*)(vb + sv * 512) = make_uint4(lo.x, lo.y, hi.x, hi.y);
            }
          }
        }
      } else {
#pragma unroll
        for (int m = 0; m < 4; ++m) {
          u16* sg = (u16*)(ws + WS_SG) + (size_t)(tb + m * 16 + fr) * 1024 + f0 + 4 * fq;
#pragma unroll
          for (int bj = 0; bj < 2; ++bj)
#pragma unroll
            for (int n = 0; n < 2; ++n) {
              float v[4];
#pragma unroll
              for (int j = 0; j < 4; ++j) { const float x = acc[ai][bj][m][n][j]; v[j] = x * __builtin_amdgcn_rcpf(1.f + __expf(-x)); }
              uint2 pk;
              pk.x = pk2(v[0], v[1]);
              pk.y = pk2(v[2], v[3]);
              *(uint2*)(sg + 32 * bj + 16 * n) = pk;
            }
        }
      }
    }
  }
};

template <int LAYER>
struct EpiOut {
  Params p;
  DEV void operator()(const f32x4 (&acc)[2][2][4][2], const pg8::Unit& u, int wr, int wc, int fr, int fq) const {
    const int col = u.pn * 256 + wc * 64 + 4 * fq;
    const size_t t0 = (size_t)(u.pm * 256 + wr * 64 + fr);
    f32x4 xr[3][4];
    auto rowp = [&](int g) { return (size_t)(t0 + (g >> 2) * 128 + (g & 3) * 16) * 1024 + col; };
    auto ldg = [&](int g, f32x4 (&x)[4]) {
      const float* xi = ((LAYER == 0) ? p.x_prompt : (const float*)p.out) + rowp(g);
#pragma unroll
      for (int q = 0; q < 4; ++q) x[q] = *(const f32x4*)(xi + 32 * (q >> 1) + 16 * (q & 1));
    };
    ldg(0, xr[0]);
    ldg(1, xr[1]);
#pragma unroll
    for (int g = 0; g < 8; ++g) {
      if (g + 2 < 8) ldg(g + 2, xr[(g + 2) % 3]);
      float* yo = p.out + rowp(g);
#pragma unroll
      for (int q = 0; q < 4; ++q) *(f32x4*)(yo + 32 * (q >> 1) + 16 * (q & 1)) = xr[g % 3][q] + acc[g >> 2][q >> 1][g & 3][q & 1];
    }
  }
};

DEV void gemm_tile(const u16* __restrict__ Wt, const u16* __restrict__ X, int n0, int m0, char* lds, f32x4 (&acc)[4][2]) {
  const int tid = opaque_tid(), lane = tid & 63, w = tid >> 6;
  const int wa = w & 1, wb = w >> 1;
  const int lr = lane & 15, lq = lane >> 4;
  const int srow = tid >> 3, skc = (tid & 7) ^ (srow & 7);
  const u16* ga = Wt + (size_t)(n0 + srow) * 1024 + skc * 8;
  const u16* gb = X + (size_t)(m0 + srow) * 1024 + skc * 8;
  typedef __attribute__((address_space(3))) unsigned lds_u32;
  typedef const __attribute__((address_space(1))) unsigned glb_u32;
#define GLDS(gp, lp) __builtin_amdgcn_global_load_lds((glb_u32*)(gp), (lds_u32*)(lp), 16, 0, 0)
#define GT_STAGE(kt) do { char* d_ = sdst + ((kt) & 3) * 32768; const int ko_ = (kt) * 64; \
    GLDS(ga + ko_, d_); GLDS(ga + (size_t)64 * 1024 + ko_, d_ + 8192); \
    GLDS(gb + ko_, d_ + 16384); GLDS(gb + (size_t)64 * 1024 + ko_, d_ + 16384 + 8192); } while (0)
#pragma unroll
  for (int mt = 0; mt < 4; ++mt)
#pragma unroll
    for (int nt = 0; nt < 2; ++nt) acc[mt][nt] = f32x4{0.f, 0.f, 0.f, 0.f};
  char* sdst = lds + tid * 16;
  __syncthreads();
  GT_STAGE(0); GT_STAGE(1); GT_STAGE(2);
  const int aoff = (wa * 64 + lr) * 128;
  const int boff = 16384 + (wb * 32 + lr) * 128;
  const int sw = lr & 7;
  for (int kt = 0; kt < 16; ++kt) {
    if (kt + 2 < 16) asm volatile("s_waitcnt vmcnt(8) lgkmcnt(0)" ::: "memory");
    else if (kt + 1 < 16) asm volatile("s_waitcnt vmcnt(4) lgkmcnt(0)" ::: "memory");
    else asm volatile("s_waitcnt vmcnt(0) lgkmcnt(0)" ::: "memory");
    __builtin_amdgcn_s_barrier();
    asm volatile("" ::: "memory");
    if (kt + 3 < 16) GT_STAGE(kt + 3);
    const char* cur = lds + (kt & 3) * 32768;
#pragma unroll
    for (int kk = 0; kk < 2; ++kk) {
      bf16x8 a[4], b[2];
      const int co = ((kk * 4 + lq) ^ sw) << 4;
#pragma unroll
      for (int mt = 0; mt < 4; ++mt) a[mt] = *(const bf16x8*)(cur + aoff + mt * 2048 + co);
#pragma unroll
      for (int nt = 0; nt < 2; ++nt) b[nt] = *(const bf16x8*)(cur + boff + nt * 2048 + co);
#pragma unroll
      for (int mt = 0; mt < 4; ++mt)
#pragma unroll
        for (int nt = 0; nt < 2; ++nt)
          acc[mt][nt] = __builtin_amdgcn_mfma_f32_16x16x32_bf16(a[mt], b[nt], acc[mt][nt], 0, 0, 0);
    }
  }
  __syncthreads();
#undef GLDS
#undef GT_STAGE
}

template <int LAYER>
DEV void inproj_epilogue(const Params& p, f32x4 (&acc)[4][2], int n0, int m0) {
  const int tid = opaque_tid(), lane = tid & 63, w = tid >> 6;
  const int wa = w & 1, wb = w >> 1;
  const int lr = lane & 15, lq = lane >> 4;
  const int region = n0 >> 10;
  const int f0 = (n0 & 1023) + wa * 64;
  const int hc = f0 >> 6;
  char* ws = p.ws;
#pragma unroll
  for (int nt = 0; nt < 2; ++nt) {
    const int t = m0 + wb * 32 + nt * 16 + lr;
    const bool samp = t >= NTOK_P;
    const int ts = t - NTOK_P;
    const int b = samp ? (ts >> 4) : (t >> 11);
    const int s = samp ? (ts & 15) : (t & 2047);
    if (region <= 1) {
      float rinv = 1.f;
      if (LAYER == 0) {
        float ss = 0.f;
#pragma unroll
        for (int mt = 0; mt < 4; ++mt)
#pragma unroll
          for (int j = 0; j < 4; ++j) ss += acc[mt][nt][j] * acc[mt][nt][j];
        ss += __shfl_xor(ss, 16);
        ss += __shfl_xor(ss, 32);
        rinv = rsqrtf(ss * (1.f / 64.f) + 1e-6f);
      }
      const float qscale = (region == 0) ? (0.125f * LOG2E) : 1.f;
      const float* gn = (region == 0) ? p.q_norm : p.k_norm;
      u16* fb;
      if (region == 0)
        fb = samp ? (u16*)(ws + WS_QFS) + (size_t)(b * 16 + hc) * 2048
                  : (u16*)(ws + WS_QF) + ((size_t)(b * 16 + hc) * 64 + (s >> 5)) * 2048;
      else
        fb = samp ? (u16*)(ws + WS_KFS) + (size_t)(b * 16 + hc) * 2048
                  : (u16*)(ws + WS_KF) + ((size_t)(b * 16 + hc) * 64 + (s >> 5)) * 2048;
      const int rr = samp ? s : (s & 31);
      float* kout = nullptr;
      if (region == 1) {
        if (LAYER == 0) kout = p.out + (samp ? OFF_K0S + (size_t)ts * 1024 : OFF_K0P + (size_t)t * 1024) + f0;
        else            kout = p.out + (samp ? OFF_K1S + (size_t)ts * 1024 : OFF_K1P + (size_t)t * 1024) + f0;
      }
#pragma unroll
      for (int mt = 0; mt < 4; ++mt) {
        float v[4];
        if (LAYER == 0) {
          const float4 g4 = *(const float4*)(gn + mt * 16 + lq * 4);
          v[0] = acc[mt][nt][0] * rinv * g4.x; v[1] = acc[mt][nt][1] * rinv * g4.y;
          v[2] = acc[mt][nt][2] * rinv * g4.z; v[3] = acc[mt][nt][3] * rinv * g4.w;
        } else {
#pragma unroll
          for (int j = 0; j < 4; ++j) v[j] = acc[mt][nt][j];
        }
        if (region == 1) *(float4*)(kout + mt * 16 + lq * 4) = make_float4(v[0], v[1], v[2], v[3]);
        uint2 pk;
        pk.x = pk2(v[0] * qscale, v[1] * qscale);
        pk.y = pk2(v[2] * qscale, v[3] * qscale);
        *(uint2*)(fb + (mt * 64 + (lq >> 1) * 32 + rr) * 8 + (lq & 1) * 4) = pk;
      }
    } else if (region == 2) {
      float* vout;
      if (LAYER == 0) vout = p.out + (samp ? OFF_V0S + (size_t)ts * 1024 : OFF_V0P + (size_t)t * 1024) + f0;
      else            vout = p.out + (samp ? OFF_V1S + (size_t)ts * 1024 : OFF_V1P + (size_t)t * 1024) + f0;
      const int kk = samp ? s : (s & 31);
      const int sv = kk >> 4, hh = (kk >> 2) & 1, jf = ((kk >> 3) & 1) * 4 + (kk & 3);
      u16* vb;
      int dbase;
      if (LAYER == 0) {
        const int h = f0 >> 7;
        dbase = f0 & 127;
        vb = samp ? (u16*)(ws + WS_VFS) + (size_t)(b * 8 + h) * 4096
                  : (u16*)(ws + WS_VF) + ((size_t)(b * 8 + h) * 64 + (s >> 5)) * 4096;
      } else {
        dbase = 0;
        vb = samp ? (u16*)(ws + WS_VFS) + (size_t)(b * 16 + hc) * 2048
                  : (u16*)(ws + WS_VF) + ((size_t)(b * 16 + hc) * 64 + (s >> 5)) * 2048;
      }
#pragma unroll
      for (int mt = 0; mt < 4; ++mt) {
        *(float4*)(vout + mt * 16 + lq * 4) = make_float4(acc[mt][nt][0], acc[mt][nt][1], acc[mt][nt][2], acc[mt][nt][3]);
#pragma unroll
        for (int j = 0; j < 4; ++j) {
          const int d = dbase + mt * 16 + lq * 4 + j;
          vb[((d >> 5) * 2 + sv) * 512 + (hh * 32 + (d & 31)) * 8 + jf] = f2bf(acc[mt][nt][j]);
        }
      }
    } else {
      u16* sg = (u16*)(ws + WS_SG) + (size_t)t * 1024 + f0;
#pragma unroll
      for (int mt = 0; mt < 4; ++mt) {
        float v[4];
#pragma unroll
        for (int j = 0; j < 4; ++j) {
          const float x = acc[mt][nt][j];
          v[j] = x * __builtin_amdgcn_rcpf(1.f + __expf(-x));
        }
        uint2 pk;
        pk.x = pk2(v[0], v[1]);
        pk.y = pk2(v[2], v[3]);
        *(uint2*)(sg + mt * 16 + lq * 4) = pk;
      }
    }
  }
}

template <int LAYER>
DEV void outproj_epilogue(const Params& p, f32x4 (&acc)[4][2], int n0, int m0) {
  const int tid = opaque_tid(), lane = tid & 63, w = tid >> 6;
  const int wa = w & 1, wb = w >> 1;
  const int lr = lane & 15, lq = lane >> 4;
#pragma unroll
  for (int nt = 0; nt < 2; ++nt) {
    const int t = m0 + wb * 32 + nt * 16 + lr;
    float* yo = p.out + (size_t)t * 1024 + n0 + wa * 64 + lq * 4;
    const float* xi;
    if (LAYER == 0)
      xi = (t >= NTOK_P ? p.x_sample + (size_t)(t - NTOK_P) * 1024 : p.x_prompt + (size_t)t * 1024) + n0 + wa * 64 + lq * 4;
    else
      xi = yo;
#pragma unroll
    for (int mt = 0; mt < 4; ++mt) {
      const float4 xv = *(const float4*)(xi + mt * 16);
      *(float4*)(yo + mt * 16) = make_float4(xv.x + acc[mt][nt][0], xv.y + acc[mt][nt][1], xv.z + acc[mt][nt][2], xv.w + acc[mt][nt][3]);
    }
  }
}

DEV void transpose_tile(const float* __restrict__ W, int N, u16* __restrict__ Wt, int k0, int n0, float* ldsf) {
  const int tid = opaque_tid();
#pragma unroll
  for (int i = 0; i < 2; ++i) {
    const int idx = tid + 512 * i;
    const int kr = idx >> 4, c4 = idx & 15;
    const float4 v = *(const float4*)(W + (size_t)(k0 + kr) * N + n0 + c4 * 4);
    float* d = ldsf + kr * 65 + c4 * 4;
    d[0] = v.x; d[1] = v.y; d[2] = v.z; d[3] = v.w;
  }
  __syncthreads();
  {
    const int n = tid >> 3, kc = tid & 7;
    float f[8];
#pragma unroll
    for (int j = 0; j < 8; ++j) f[j] = ldsf[(kc * 8 + j) * 65 + n];
    uint4 o = make_uint4(pk2(f[0], f[1]), pk2(f[2], f[3]), pk2(f[4], f[5]), pk2(f[6], f[7]));
    *(uint4*)(Wt + (size_t)(n0 + n) * 1024 + k0 + kc * 8) = o;
  }
  __syncthreads();
}

template <class SrcOf>
DEV void norm_rows(SrcOf src_of, const float* __restrict__ g, u16* __restrict__ dst, int row0, int stride, int lane) {
  float4 cur[4], nxt[4];
  if (row0 < NTOK) {
    const float4* s = (const float4*)src_of(row0);
#pragma unroll
    for (int i = 0; i < 4; ++i) cur[i] = s[lane + 64 * i];
  }
  for (int row = row0; row < NTOK; row += stride) {
    const int nr = row + stride;
    if (nr < NTOK) {
      const float4* s = (const float4*)src_of(nr);
#pragma unroll
      for (int i = 0; i < 4; ++i) nxt[i] = s[lane + 64 * i];
    }
    float ss = 0.f;
#pragma unroll
    for (int i = 0; i < 4; ++i) ss += cur[i].x * cur[i].x + cur[i].y * cur[i].y + cur[i].z * cur[i].z + cur[i].w * cur[i].w;
    ss = wave_sum(ss);
    const float rn = rsqrtf(ss * (1.f / 1024.f) + 1e-6f);
    uint2* d = (uint2*)(dst + (size_t)row * 1024);
#pragma unroll
    for (int i = 0; i < 4; ++i) {
      const float4 gg = ((const float4*)g)[lane + 64 * i];
      uint2 o;
      o.x = pk2(cur[i].x * rn * gg.x, cur[i].y * rn * gg.y);
      o.y = pk2(cur[i].z * rn * gg.z, cur[i].w * rn * gg.w);
      d[lane + 64 * i] = o;
    }
#pragma unroll
    for (int i = 0; i < 4; ++i) cur[i] = nxt[i];
  }
}

DEV void attn0_ptile(const f32x16& S, float base, float slope2, bool first_half_only, float& l, unsigned (&pw)[8]) {
#pragma unroll
  for (int i = 0; i < 16; i += 2) {
    const float ca = (float)((i & 3) + 8 * (i >> 2));
    const float cb = (float)(((i + 1) & 3) + 8 * ((i + 1) >> 2));
    float ea = ex2(fmaf(-slope2, fabsf(base - ca), S[i]));
    float eb = ex2(fmaf(-slope2, fabsf(base - cb), S[i + 1]));
    if (first_half_only && i >= 8) { ea = 0.f; eb = 0.f; }
    l += ea + eb;
    pw[i >> 1] = pk2(ea, eb);
  }
}

DEV void attn0_finish(const Params& p, f32x16 (&O)[4], size_t t, int h, int hh, bool valid) {
  float ss = 0.f;
#pragma unroll
  for (int db = 0; db < 4; ++db)
#pragma unroll
    for (int i = 0; i < 16; ++i) ss += O[db][i] * O[db][i];
  ss += __shfl_xor(ss, 32);
  const float rn = rsqrtf(ss * (1.f / 128.f) + 1e-6f) * 0.8f;
  if (valid) {
    const u16* sgp = (const u16*)(p.ws + WS_SG) + t * 1024 + h * 128;
    u16* ogp = (u16*)(p.ws + WS_ACT) + t * 1024 + h * 128;
#pragma unroll
    for (int db = 0; db < 4; ++db)
#pragma unroll
      for (int g = 0; g < 4; ++g) {
        const int d = db * 32 + 8 * g + 4 * hh;
        const float4 gn = *(const float4*)(p.subln_g + d);
        const uint2 gt = *(const uint2*)(sgp + d);
        uint2 o;
        o.x = pk2(O[db][4 * g + 0] * rn * gn.x * bflo(gt.x), O[db][4 * g + 1] * rn * gn.y * bfhi(gt.x));
        o.y = pk2(O[db][4 * g + 2] * rn * gn.z * bflo(gt.y), O[db][4 * g + 3] * rn * gn.w * bfhi(gt.y));
        *(uint2*)(ogp + d) = o;
      }
  }
}

DEV void attn0_prompt(const Params& p, int b, int h, int cp, int kt0, char* lds, int lane, int w, float neg_lam) {
  const int pair = w >> 1, comp = w & 1;
  const int r = lane & 31, hh = lane >> 5;
  const int qblk = 4 * cp + pair;
  const int my_nt = 2 * ((qblk >> 1) + 1);
  const int NT = 4 * cp + 4;
  char* ws = p.ws;
  typedef __attribute__((address_space(3))) unsigned lds_u32;
  typedef const __attribute__((address_space(1))) unsigned glb_u32;
  char* qst = lds + 65536 + w * 8192 + lane * 16;
  {
    const u16* qb = (const u16*)(ws + WS_QF) + ((size_t)(b * 16 + 2 * h + comp) * 64 + qblk) * 2048 + lane * 8;
#pragma unroll
    for (int s = 0; s < 4; ++s) __builtin_amdgcn_global_load_lds((glb_u32*)(qb + s * 512), (lds_u32*)(qst + s * 1024), 16, 0, 0);
  }
  const u16* src0;
  size_t tstride;
  if (w < 4) { src0 = (const u16*)(ws + WS_KF) + (size_t)(b * 16 + 2 * h + (w >> 1)) * 64 * 2048 + ((2 * w) & 3) * 512 + lane * 8; tstride = 2048; }
  else       { src0 = (const u16*)(ws + WS_VF) + (size_t)(b * 8 + h) * 64 * 4096 + (2 * w - 8) * 512 + lane * 8; tstride = 4096; }
  char* dst0 = lds + (2 * w) * 1024 + lane * 16;
#define ATT_DMA(kt) do { const u16* s_ = src0 + (size_t)(kt) * tstride; char* d_ = dst0 + ((kt) & 3) * 16384; \
    __builtin_amdgcn_global_load_lds((glb_u32*)s_, (lds_u32*)d_, 16, 0, 0); \
    __builtin_amdgcn_global_load_lds((glb_u32*)(s_ + 512), (lds_u32*)(d_ + 1024), 16, 0, 0); } while (0)
  ATT_DMA(kt0); ATT_DMA(kt0 + 1); ATT_DMA(kt0 + 2);
  asm volatile("s_waitcnt vmcnt(6)" ::: "memory");
  bf16x8 qf[4];
#pragma unroll
  for (int s = 0; s < 4; ++s) qf[s] = *(const bf16x8*)(qst + s * 1024);
  f32x16 O[4];
#pragma unroll
  for (int db = 0; db < 4; ++db)
#pragma unroll
    for (int i = 0; i < 16; ++i) O[db][i] = 0.f;
  float l = 0.f;
  const float slope2 = exp2f(-(float)(h + 1)) * LOG2E;
  const float qposf = (float)(qblk * 32 + r);
  for (int kt = kt0; kt < NT; ++kt) {
    if (kt + 2 < NT) asm volatile("s_waitcnt vmcnt(4) lgkmcnt(0)" ::: "memory");
    else if (kt + 1 < NT) asm volatile("s_waitcnt vmcnt(2) lgkmcnt(0)" ::: "memory");
    else asm volatile("s_waitcnt vmcnt(0) lgkmcnt(0)" ::: "memory");
    __builtin_amdgcn_s_barrier();
    asm volatile("" ::: "memory");
    if (kt + 3 < NT) ATT_DMA(kt + 3);
    if (kt < my_nt) {
      const char* img = lds + (kt & 3) * 16384 + lane * 16;
      bf16x8 kf[4], vf[4][2];
#pragma unroll
      for (int s = 0; s < 4; ++s) kf[s] = *(const bf16x8*)(img + (comp * 4 + s) * 1024);
      __builtin_amdgcn_sched_barrier(0);
      f32x16 S;
#pragma unroll
      for (int i = 0; i < 16; ++i) S[i] = 0.f;
#pragma unroll
      for (int s = 0; s < 4; ++s) S = __builtin_amdgcn_mfma_f32_32x32x16_bf16(kf[s], qf[s], S, 0, 0, 0);
      __builtin_amdgcn_sched_barrier(0);
#pragma unroll
      for (int db = 0; db < 4; ++db)
#pragma unroll
        for (int s = 0; s < 2; ++s) vf[db][s] = *(const bf16x8*)(img + (8 + db * 2 + s) * 1024);
      __builtin_amdgcn_sched_barrier(0);
      unsigned pw[8];
      attn0_ptile(S, qposf - (float)(kt * 32 + 4 * hh), slope2, false, l, pw);
#pragma unroll
      for (int s = 0; s < 2; ++s) {
        const bf16x8 pf = mk8(pw[4 * s], pw[4 * s + 1], pw[4 * s + 2], pw[4 * s + 3]);
#pragma unroll
        for (int db = 0; db < 4; ++db) O[db] = __builtin_amdgcn_mfma_f32_32x32x16_bf16(vf[db][s], pf, O[db], 0, 0, 0);
      }
    }
  }
#undef ATT_DMA
  l += __shfl_xor(l, 32);
  float* ldsx = (float*)(lds + 65536 + pair * 16384);
  if (comp == 1) {
    const float c2 = neg_lam / l;
#pragma unroll
    for (int db = 0; db < 4; ++db)
#pragma unroll
      for (int i = 0; i < 16; ++i) ldsx[(db * 16 + i) * 64 + lane] = c2 * O[db][i];
  }
  __syncthreads();
  if (comp == 0) {
    const float c1 = 1.f / l;
#pragma unroll
    for (int db = 0; db < 4; ++db)
#pragma unroll
      for (int i = 0; i < 16; ++i) O[db][i] = c1 * O[db][i] + ldsx[(db * 16 + i) * 64 + lane];
    attn0_finish(p, O, (size_t)b * 2048 + qblk * 32 + r, h, hh, true);
  }
}

DEV void attn0_sample(const Params& p, int b, int h, char* lds, int lane, int w, float neg_lam) {
  const int pair = w >> 1, comp = w & 1;
  const int r = lane & 31, hh = lane >> 5;
  char* ws = p.ws;
  bf16x8 qf[4];
  {
    const u16* qb = (const u16*)(ws + WS_QFS) + (size_t)(b * 16 + 2 * h + comp) * 2048;
#pragma unroll
    for (int s = 0; s < 4; ++s) qf[s] = *(const bf16x8*)(qb + s * 512 + lane * 8);
  }
  const int kt0 = pair * 16, kt1 = kt0 + 16 + (pair == 3 ? 1 : 0);
  const float slope2 = exp2f(-(float)(h + 1)) * LOG2E;
  const float qposf = (float)(2048 + r);
  bf16x8 kf[4], vf[4][2];
  auto load_k = [&](int kt) {
    if (kt < 64) {
      const float* base = p.ck0 + (((size_t)b * 2048 + kt * 32 + r) * 8 + h) * 128 + comp * 64 + 8 * hh;
#pragma unroll
      for (int s = 0; s < 4; ++s) {
        const float4 u0 = *(const float4*)(base + 16 * s);
        const float4 u1 = *(const float4*)(base + 16 * s + 4);
        kf[s] = mk8(pk2(u0.x, u0.y), pk2(u0.z, u0.w), pk2(u1.x, u1.y), pk2(u1.z, u1.w));
      }
    } else {
      const u16* kb = (const u16*)(ws + WS_KFS) + (size_t)(b * 16 + 2 * h + comp) * 2048;
#pragma unroll
      for (int s = 0; s < 4; ++s) kf[s] = *(const bf16x8*)(kb + s * 512 + lane * 8);
    }
  };
  auto load_v = [&](int kt) {
    if (kt < 64) {
      const float* base = p.cv0 + (((size_t)b * 2048 + kt * 32 + 4 * hh) * 8 + h) * 128 + r;
#pragma unroll
      for (int db = 0; db < 4; ++db)
#pragma unroll
        for (int s = 0; s < 2; ++s) {
          float f[8];
#pragma unroll
          for (int j = 0; j < 8; ++j) f[j] = base[(size_t)(16 * s + 8 * (j >> 2) + (j & 3)) * 1024 + db * 32];
          vf[db][s] = mk8(pk2(f[0], f[1]), pk2(f[2], f[3]), pk2(f[4], f[5]), pk2(f[6], f[7]));
        }
    } else {
      const u16* vb = (const u16*)(ws + WS_VFS) + (size_t)(b * 8 + h) * 4096;
#pragma unroll
      for (int db = 0; db < 4; ++db)
#pragma unroll
        for (int s = 0; s < 2; ++s) vf[db][s] = *(const bf16x8*)(vb + (db * 2 + s) * 512 + lane * 8);
    }
  };
  f32x16 O[4];
#pragma unroll
  for (int db = 0; db < 4; ++db)
#pragma unroll
    for (int i = 0; i < 16; ++i) O[db][i] = 0.f;
  float l = 0.f;
  load_k(kt0);
  load_v(kt0);
  for (int kt = kt0; kt < kt1; ++kt) {
    f32x16 S;
#pragma unroll
    for (int i = 0; i < 16; ++i) S[i] = 0.f;
#pragma unroll
    for (int s = 0; s < 4; ++s) S = __builtin_amdgcn_mfma_f32_32x32x16_bf16(kf[s], qf[s], S, 0, 0, 0);
    if (kt + 1 < kt1) load_k(kt + 1);
    unsigned pw[8];
    attn0_ptile(S, qposf - (float)(kt * 32 + 4 * hh), slope2, kt == 64, l, pw);
#pragma unroll
    for (int s = 0; s < 2; ++s) {
      const bf16x8 pf = mk8(pw[4 * s], pw[4 * s + 1], pw[4 * s + 2], pw[4 * s + 3]);
#pragma unroll
      for (int db = 0; db < 4; ++db) O[db] = __builtin_amdgcn_mfma_f32_32x32x16_bf16(vf[db][s], pf, O[db], 0, 0, 0);
    }
    if (kt + 1 < kt1) load_v(kt + 1);
  }
  float* slot = (float*)lds;
  float* lsum = (float*)(lds + 131072);
#pragma unroll
  for (int db = 0; db < 4; ++db)
#pragma unroll
    for (int i = 0; i < 16; ++i) slot[(w * 64 + db * 16 + i) * 64 + lane] = O[db][i];
  lsum[w * 64 + lane] = l;
  __syncthreads();
  if (w == 0) {
    float l1 = 0.f, l2 = 0.f;
#pragma unroll
    for (int q = 0; q < 4; ++q) { l1 += lsum[(2 * q) * 64 + lane]; l2 += lsum[(2 * q + 1) * 64 + lane]; }
    l1 += __shfl_xor(l1, 32);
    l2 += __shfl_xor(l2, 32);
    const float c1 = 1.f / l1, c2 = neg_lam / l2;
#pragma unroll
    for (int db = 0; db < 4; ++db)
#pragma unroll
      for (int i = 0; i < 16; ++i) {
        float o1 = 0.f, o2 = 0.f;
#pragma unroll
        for (int q = 0; q < 4; ++q) {
          o1 += slot[((2 * q) * 64 + db * 16 + i) * 64 + lane];
          o2 += slot[((2 * q + 1) * 64 + db * 16 + i) * 64 + lane];
        }
        O[db][i] = c1 * o1 + c2 * o2;
      }
    attn0_finish(p, O, (size_t)(NTOK_P + b * 16 + r), h, hh, r < 16);
  }
}

template <bool SAMPLE>
DEV void attn1_run(const Params& p, int b, int h, int qblk, int lane) {
  const int r = lane & 31, hh = lane >> 5;
  char* ws = p.ws;
  bf16x8 qf[4];
  {
    const u16* qb = SAMPLE ? (const u16*)(ws + WS_QFS) + (size_t)(b * 16 + h) * 2048
                           : (const u16*)(ws + WS_QF) + ((size_t)(b * 16 + h) * 64 + qblk) * 2048;
#pragma unroll
    for (int s = 0; s < 4; ++s) qf[s] = *(const bf16x8*)(qb + s * 512 + lane * 8);
  }
  const u16* kfb = (const u16*)(ws + WS_KF) + (size_t)(b * 16 + h) * 64 * 2048;
  const u16* vfb = (const u16*)(ws + WS_VF) + (size_t)(b * 16 + h) * 64 * 2048;
  const int ntot = SAMPLE ? 65 : (qblk + 1);
  auto load_k = [&](int it, bf16x8 (&kf)[4]) {
    if (SAMPLE && it > 0) {
      const int kt = 64 - it;
      const float* base = p.ck1 + (((size_t)b * 2048 + kt * 32 + r) * 16 + h) * 64 + 8 * hh;
#pragma unroll
      for (int s = 0; s < 4; ++s) {
        const float4 u0 = *(const float4*)(base + 16 * s);
        const float4 u1 = *(const float4*)(base + 16 * s + 4);
        kf[s] = mk8(pk2(u0.x, u0.y), pk2(u0.z, u0.w), pk2(u1.x, u1.y), pk2(u1.z, u1.w));
      }
    } else if (SAMPLE) {
      const u16* kb = (const u16*)(ws + WS_KFS) + (size_t)(b * 16 + h) * 2048;
#pragma unroll
      for (int s = 0; s < 4; ++s) kf[s] = *(const bf16x8*)(kb + s * 512 + lane * 8);
    } else {
      const u16* kb = kfb + (size_t)(qblk - it) * 2048;
#pragma unroll
      for (int s = 0; s < 4; ++s) kf[s] = *(const bf16x8*)(kb + s * 512 + lane * 8);
    }
  };
  auto load_v = [&](int it, bf16x8 (&vf)[2][2]) {
    if (SAMPLE && it > 0) {
      const int kt = 64 - it;
      const float* base = p.cv1 + (((size_t)b * 2048 + kt * 32 + 4 * hh) * 16 + h) * 64 + r;
#pragma unroll
      for (int db = 0; db < 2; ++db)
#pragma unroll
        for (int s = 0; s < 2; ++s) {
          float f[8];
#pragma unroll
          for (int j = 0; j < 8; ++j) f[j] = base[(size_t)(16 * s + 8 * (j >> 2) + (j & 3)) * 1024 + db * 32];
          vf[db][s] = mk8(pk2(f[0], f[1]), pk2(f[2], f[3]), pk2(f[4], f[5]), pk2(f[6], f[7]));
        }
    } else if (SAMPLE) {
      const u16* vb = (const u16*)(ws + WS_VFS) + (size_t)(b * 16 + h) * 2048;
#pragma unroll
      for (int db = 0; db < 2; ++db)
#pragma unroll
        for (int s = 0; s < 2; ++s) vf[db][s] = *(const bf16x8*)(vb + (db * 2 + s) * 512 + lane * 8);
    } else {
      const u16* vb = vfb + (size_t)(qblk - it) * 2048;
#pragma unroll
      for (int db = 0; db < 2; ++db)
#pragma unroll
        for (int s = 0; s < 2; ++s) vf[db][s] = *(const bf16x8*)(vb + (db * 2 + s) * 512 + lane * 8);
    }
  };

  f32x16 O[2];
#pragma unroll
  for (int db = 0; db < 2; ++db)
#pragma unroll
    for (int i = 0; i < 16; ++i) O[db][i] = 0.f;
  float carry = 0.f;
  const bool qvalid = !SAMPLE || r < 16;

  auto process = [&](int it, bf16x8 (&kf)[4], bf16x8 (&vf)[2][2]) -> bool {
    f32x16 S;
#pragma unroll
    for (int i = 0; i < 16; ++i) S[i] = 0.f;
#pragma unroll
    for (int s = 0; s < 4; ++s) S = __builtin_amdgcn_mfma_f32_32x32x16_bf16(kf[s], qf[s], S, 0, 0, 0);
    if (it + 2 < ntot) load_k(it + 2, kf);
    const int thr = (it == 0) ? (r - 4 * hh) : 1000;
    float x[16], lb[16];
#pragma unroll
    for (int i = 0; i < 16; ++i) {
      const int ci = (i & 3) + 8 * (i >> 2);
      const float z2 = S[i];
      const float e = ex2(z2);
      const float L = lg2(1.f + e);
      const bool valid = ci < thr;
      x[i] = valid ? -L : 0.f;
      lb[i] = z2 - L;
    }
    float T[4], Tp[4];
#pragma unroll
    for (int g = 0; g < 4; ++g) {
      T[g] = (x[4 * g] + x[4 * g + 1]) + (x[4 * g + 2] + x[4 * g + 3]);
      Tp[g] = __shfl_xor(T[g], 32);
    }
    float su[4];
    su[3] = 0.f;
    su[2] = T[3] + Tp[3];
    su[1] = su[2] + (T[2] + Tp[2]);
    su[0] = su[1] + (T[1] + Tp[1]);
    const float total = su[0] + (T[0] + Tp[0]);
    unsigned pw[8];
#pragma unroll
    for (int g = 0; g < 4; ++g) {
      const float gs = carry + su[g] + (hh == 0 ? Tp[g] : 0.f);
      const float a3 = gs;
      const float a2 = a3 + x[4 * g + 3];
      const float a1 = a2 + x[4 * g + 2];
      const float a0 = a1 + x[4 * g + 1];
      const int c0 = 8 * g;
      const float w0 = (c0 + 0 < thr) ? ex2(lb[4 * g + 0] + a0) : 0.f;
      const float w1 = (c0 + 1 < thr) ? ex2(lb[4 * g + 1] + a1) : 0.f;
      const float w2 = (c0 + 2 < thr) ? ex2(lb[4 * g + 2] + a2) : 0.f;
      const float w3 = (c0 + 3 < thr) ? ex2(lb[4 * g + 3] + a3) : 0.f;
      pw[2 * g] = pk2(w0, w1);
      pw[2 * g + 1] = pk2(w2, w3);
    }
    carry += total;
#pragma unroll
    for (int s = 0; s < 2; ++s) {
      const bf16x8 pf = mk8(pw[4 * s], pw[4 * s + 1], pw[4 * s + 2], pw[4 * s + 3]);
#pragma unroll
      for (int db = 0; db < 2; ++db) O[db] = __builtin_amdgcn_mfma_f32_32x32x16_bf16(vf[db][s], pf, O[db], 0, 0, 0);
    }
    if (__all((carry < -64.f) || !qvalid)) return true;
    if (it + 2 < ntot) load_v(it + 2, vf);
    return false;
  };

  bf16x8 kA[4], kB[4], vA[2][2], vB[2][2];
  load_k(0, kA);
  load_v(0, vA);
  if (ntot > 1) { load_k(1, kB); load_v(1, vB); }
  for (int it = 0; it < ntot; it += 2) {
    if (process(it, kA, vA)) break;
    if (it + 1 >= ntot) break;
    if (process(it + 1, kB, vB)) break;
  }
  if (qvalid) {
    const size_t t = SAMPLE ? (size_t)(NTOK_P + b * 16 + r) : ((size_t)b * 2048 + qblk * 32 + r);
    const u16* sgp = (const u16*)(ws + WS_SG) + t * 1024 + h * 64;
    u16* ogp = (u16*)(ws + WS_ACT) + t * 1024 + h * 64;
#pragma unroll
    for (int db = 0; db < 2; ++db)
#pragma unroll
      for (int g = 0; g < 4; ++g) {
        const int d = db * 32 + 8 * g + 4 * hh;
        const uint2 gt = *(const uint2*)(sgp + d);
        uint2 o;
        o.x = pk2(O[db][4 * g + 0] * bflo(gt.x), O[db][4 * g + 1] * bfhi(gt.x));
        o.y = pk2(O[db][4 * g + 2] * bflo(gt.y), O[db][4 * g + 3] * bfhi(gt.y));
        *(uint2*)(ogp + d) = o;
      }
  }
}

#define XB_TMO      128
#define XB_XCNT(j)  (256  + 64 * (j))
#define XB_XSUB(j)  (1280 + 64 * (j))
#define XB_XGEN(j)  (2304 + 64 * (j))
#define XB_TOP      3328
#define XB_TOPGEN   3392
#define XCD_BAR_WORDS 3456
#define XB_SPIN_CAP (1u << 18)
#define XB_LAS __attribute__((address_space(3)))
DEV unsigned xb_ld(unsigned* p)              { return __hip_atomic_load(p, __ATOMIC_RELAXED, __HIP_MEMORY_SCOPE_AGENT); }
DEV unsigned xb_add(unsigned* p, unsigned v) { return __hip_atomic_fetch_add(p, v, __ATOMIC_RELAXED, __HIP_MEMORY_SCOPE_AGENT); }
DEV unsigned xb_xcc_id() { return (unsigned)__builtin_amdgcn_s_getreg((3 << 11) | 20) & 0xFu; }
#define XB_SPIN(cond, bar) do { unsigned _sp = 0; while (cond) { __builtin_amdgcn_s_sleep(1); \
    if ((++_sp & 255u) == 0u) { if (xb_ld(&(bar)[XB_TMO])) break; if (_sp > XB_SPIN_CAP) { atomicAdd(&(bar)[XB_TMO], 1u); break; } } } } while (0)
struct XcdBarrier { unsigned* bar; unsigned x; volatile XB_LAS unsigned* st; };
DEV XcdBarrier xcd_barrier_post(unsigned* bar, volatile XB_LAS unsigned* st) {
  XcdBarrier b; b.bar = bar; b.x = xb_xcc_id(); b.st = st;
  if (threadIdx.x == 0) (void)xb_add(&bar[XB_XCNT(b.x)], 1u);
  return b;
}
DEV void xcd_barrier_complete(unsigned* bar, unsigned x, unsigned& nloc, unsigned& nx) {
  const unsigned G = gridDim.x * gridDim.y * gridDim.z;
  unsigned sum, cnt, mine, sp = 0u;
  for (;;) {
    sum = 0u; cnt = 0u; mine = 0u;
#pragma unroll
    for (unsigned j = 0; j < 16; ++j) { const unsigned c = xb_ld(&bar[XB_XCNT(j)]); sum += c; cnt += (c > 0u) ? 1u : 0u; mine = (j == x) ? c : mine; }
    if (sum == G) break;
    __builtin_amdgcn_s_sleep(1);
    if ((++sp & 255u) == 0u) { if (xb_ld(&bar[XB_TMO])) break; if (sp > XB_SPIN_CAP) { atomicAdd(&bar[XB_TMO], 1u); break; } }
  }
  nloc = mine > 0u ? mine : 1u; nx = cnt > 0u ? cnt : 1u;
}
DEV void xcd_barrier(const XcdBarrier& b) {
  asm volatile("s_waitcnt vmcnt(0)" ::: "memory");
  __syncthreads();
  if (threadIdx.x == 0) {
    unsigned* bar = b.bar;
    __builtin_amdgcn_s_waitcnt(0);
    unsigned nloc = b.st[0], nx = b.st[1];
    if (nloc == 0u) { xcd_barrier_complete(bar, b.x, nloc, nx); b.st[0] = nloc; b.st[1] = nx; }
    const unsigned old = xb_add(&bar[XB_XSUB(b.x)], 1u);
    const unsigned gen = old / nloc;
    if (old + 1u == (gen + 1u) * nloc) {
      __builtin_amdgcn_fence(__ATOMIC_RELEASE, "agent");
      asm volatile("s_waitcnt vmcnt(0)" ::: "memory");
      const unsigned og = xb_add(&bar[XB_TOP], 1u);
      const unsigned tg = og / nx;
      if (og + 1u == (tg + 1u) * nx) xb_add(&bar[XB_TOPGEN], 1u);
      else XB_SPIN(xb_ld(&bar[XB_TOPGEN]) == tg, bar);
      __builtin_amdgcn_fence(__ATOMIC_ACQUIRE, "agent");
      xb_add(&bar[XB_XGEN(b.x)], 1u);
      asm volatile("s_waitcnt vmcnt(0)" ::: "memory");
    } else {
      XB_SPIN(xb_ld(&bar[XB_XGEN(b.x)]) == gen, bar);
      __builtin_amdgcn_fence(__ATOMIC_ACQUIRE, "agent");
      asm volatile("s_waitcnt vmcnt(0)" ::: "memory");
    }
  }
  __syncthreads();
}

DEV int fetch_unit(unsigned* ctr, int lane) {
  unsigned v = 0;
  if (lane == 0) v = atomicAdd(ctr, 1u);
  return (int)__builtin_amdgcn_readfirstlane(v);
}

__global__ void __launch_bounds__(512, 2) fwd_megakernel(Params p) {
  extern __shared__ __attribute__((aligned(16))) char lds[];
  __shared__ unsigned s_misc[4];
#define s_unit (*(int*)&s_misc[0])
  cg::grid_group grid = cg::this_grid();
#define PHASE_IDS() int tid = threadIdx.x; asm volatile("" : "+v"(tid)); const int lane = tid & 63, w = tid >> 6; const int gw = bid * 8 + w; (void)lane; (void)gw;
  const int nblk = gridDim.x, bid = blockIdx.x;
  const int ngw = nblk * 8;
  char* ws = p.ws;
  unsigned* cnt = (unsigned*)(ws + WS_CNT);
  PG8_LAS unsigned char* ldsg = (PG8_LAS unsigned char*)lds;
  pg8::StaticOrder S;

  if (p.ws == nullptr) grid.sync();
  const XcdBarrier xbar = xcd_barrier_post((unsigned*)(ws + WS_BAR), (volatile XB_LAS unsigned*)&s_misc[1]);

  {
  PHASE_IDS();
  if (tid < 4) s_misc[tid] = 0u;
  {
    uint4* z = (uint4*)(ws + WS_QFS);
    for (int i = bid * 512 + tid; i < 98304; i += nblk * 512) z[i] = make_uint4(0, 0, 0, 0);
  }
  for (int id = bid; id < 2560; id += nblk) {
    if (id < 1024)      transpose_tile(p.w_in0, 4096, (u16*)(ws + WS_WT_IN0), (id >> 6) * 64, (id & 63) * 64, (float*)lds);
    else if (id < 1280) transpose_tile(p.w_out0, 1024, (u16*)(ws + WS_WT_OUT0), ((id - 1024) >> 4) * 64, ((id - 1024) & 15) * 64, (float*)lds);
    else if (id < 2304) transpose_tile(p.w_in1, 4096, (u16*)(ws + WS_WT_IN1), ((id - 1280) >> 6) * 64, ((id - 1280) & 63) * 64, (float*)lds);
    else                transpose_tile(p.w_out1, 1024, (u16*)(ws + WS_WT_OUT1), ((id - 2304) >> 4) * 64, ((id - 2304) & 15) * 64, (float*)lds);
  }
  norm_rows([&](int row) { return row < NTOK_P ? p.x_prompt + (size_t)row * 1024 : p.x_sample + (size_t)(row - NTOK_P) * 1024; },
            p.norm_g0, (u16*)(ws + WS_ACT), gw, ngw, lane);
  }
  xcd_barrier(xbar);

  {
    S.init(NTOK_P, 4096, nblk, bid);
    pg8::Gemm g{(const u16*)(ws + WS_ACT), (const u16*)(ws + WS_WT_IN0), NTOK_P, 4096, 1024};
    EpiIn<0> E{p, lds + pg8::STAGE_BYTES};
    pg8::gemm_phase(ldsg, g, S, E);
    for (int st = bid; st < 32; st += nblk) {
      f32x4 acc[4][2];
      gemm_tile((const u16*)(ws + WS_WT_IN0), (const u16*)(ws + WS_ACT), st * 128, NTOK_P, lds, acc);
      inproj_epilogue<0>(p, acc, st * 128, NTOK_P);
    }
  }
  xcd_barrier(xbar);

  {
    PHASE_IDS();
    float a1 = p.lq1[lane] * p.lk1[lane], a2 = p.lq2[lane] * p.lk2[lane];
    a1 = wave_sum(a1);
    a2 = wave_sum(a2);
    const float lam = __expf(a1) - __expf(a2) + 0.2f;
    const int wu = __builtin_amdgcn_readfirstlane(w);
    float gq = fabsf(p.q_norm[lane]), gk = fabsf(p.k_norm[lane]);
#pragma unroll
    for (int o = 32; o; o >>= 1) { gq = fmaxf(gq, __shfl_xor(gq, o)); gk = fmaxf(gk, __shfl_xor(gk, o)); }
    const float smax2 = 8.f * gq * gk * LOG2E * 1.02f;
    for (;;) {
      __syncthreads();
      if (tid == 0) s_unit = (int)atomicAdd(cnt + 0, 1u);
      __syncthreads();
      const int u = s_unit;
      if (u >= 64 + 2048) break;
      if (u < 64) attn0_sample(p, u >> 3, u & 7, lds, lane, wu, -lam);
      else {
        const int v = u - 64;
        const int hh_ = v & 7, cp_ = 15 - (v >> 7);
        const float dmin = (2.f * smax2 + 75.f) / (exp2f(-(float)(hh_ + 1)) * LOG2E);
        int kt0 = 0;
        if (dmin < 4096.f) {
          const int num = 128 * cp_ - 31 - (int)ceilf(dmin);
          if (num >= 0) kt0 = num / 32 + 1;
        }
        kt0 = __builtin_amdgcn_readfirstlane(kt0);
        attn0_prompt(p, (v & 127) >> 3, hh_, cp_, kt0, lds, lane, wu, -lam);
      }
    }
  }
  xcd_barrier(xbar);

  {
    S.init(NTOK_P, 1024, nblk, bid);
    pg8::Gemm g{(const u16*)(ws + WS_ACT), (const u16*)(ws + WS_WT_OUT0), NTOK_P, 1024, 1024};
    EpiOut<0> E{p};
    pg8::gemm_phase(ldsg, g, S, E);
    for (int st = bid; st < 8; st += nblk) {
      f32x4 acc[4][2];
      gemm_tile((const u16*)(ws + WS_WT_OUT0), (const u16*)(ws + WS_ACT), st * 128, NTOK_P, lds, acc);
      outproj_epilogue<0>(p, acc, st * 128, NTOK_P);
    }
  }
  xcd_barrier(xbar);

  {
    PHASE_IDS();
    norm_rows([&](int row) { return (const float*)(p.out + (size_t)row * 1024); }, p.norm_g1, (u16*)(ws + WS_ACT), gw, ngw, lane);
  }
  xcd_barrier(xbar);

  {
    S.init(NTOK_P, 4096, nblk, bid);
    pg8::Gemm g{(const u16*)(ws + WS_ACT), (const u16*)(ws + WS_WT_IN1), NTOK_P, 4096, 1024};
    EpiIn<1> E{p, lds + pg8::STAGE_BYTES};
    pg8::gemm_phase(ldsg, g, S, E);
    for (int st = bid; st < 32; st += nblk) {
      f32x4 acc[4][2];
      gemm_tile((const u16*)(ws + WS_WT_IN1), (const u16*)(ws + WS_ACT), st * 128, NTOK_P, lds, acc);
      inproj_epilogue<1>(p, acc, st * 128, NTOK_P);
    }
  }
  xcd_barrier(xbar);

  {
  PHASE_IDS();
  for (int u = gw; u < 128 + 16384; u += ngw) {
    if (u < 128) attn1_run<true>(p, u >> 4, u & 15, 0, lane);
    else {
      const int v = u - 128;
      attn1_run<false>(p, (v & 255) >> 4, v & 15, 63 - (v >> 8), lane);
    }
  }
  }
  xcd_barrier(xbar);

  {
    S.init(NTOK_P, 1024, nblk, bid);
    pg8::Gemm g{(const u16*)(ws + WS_ACT), (const u16*)(ws + WS_WT_OUT1), NTOK_P, 1024, 1024};
    EpiOut<1> E{p};
    pg8::gemm_phase(ldsg, g, S, E);
    for (int st = bid; st < 8; st += nblk) {
      f32x4 acc[4][2];
      gemm_tile((const u16*)(ws + WS_WT_OUT1), (const u16*)(ws + WS_ACT), st * 128, NTOK_P, lds, acc);
      outproj_epilogue<1>(p, acc, st * 128, NTOK_P);
    }
  }
}

extern "C" void kernel_launch(void* const* d_in, const int* in_sizes, int n_in, void* d_out, int out_size, void* d_ws,
                              size_t ws_size, hipStream_t stream) {
  Params p{};
  p.x_prompt = (const float*)d_in[0]; p.x_sample = (const float*)d_in[1];
  p.ck0 = (const float*)d_in[2]; p.cv0 = (const float*)d_in[3]; p.ck1 = (const float*)d_in[4]; p.cv1 = (const float*)d_in[5];
  p.norm_g0 = (const float*)d_in[6]; p.w_in0 = (const float*)d_in[7]; p.q_norm = (const float*)d_in[8]; p.k_norm = (const float*)d_in[9];
  p.lq1 = (const float*)d_in[10]; p.lk1 = (const float*)d_in[11]; p.lq2 = (const float*)d_in[12]; p.lk2 = (const float*)d_in[13];
  p.subln_g = (const float*)d_in[14]; p.w_out0 = (const float*)d_in[15]; p.norm_g1 = (const float*)d_in[16];
  p.w_in1 = (const float*)d_in[17]; p.w_out1 = (const float*)d_in[18];
  p.out = (float*)d_out;
  p.ws = (char*)d_ws;
  static int grid_blocks = 0;
  if (!grid_blocks) {
    int dev = 0, cus = 0, per_cu = 0;
    hipGetDevice(&dev);
    hipFuncSetAttribute((const void*)fwd_megakernel, hipFuncAttributeMaxDynamicSharedMemorySize, LDS_BYTES);
    hipDeviceGetAttribute(&cus, hipDeviceAttributeMultiprocessorCount, dev);
    hipOccupancyMaxActiveBlocksPerMultiprocessor(&per_cu, fwd_megakernel, 512, LDS_BYTES);
    if (per_cu < 1) per_cu = 1;
    if (per_cu > 1) per_cu = 1;
    grid_blocks = cus * per_cu;
  }
  hipMemsetAsync((char*)d_ws + WS_CNT, 0, 256 + XCD_BAR_WORDS * 4, stream);
  void* args[] = {&p};
  hipError_t e = hipLaunchCooperativeKernel((void*)fwd_megakernel, dim3(grid_blocks), dim3(512), args, LDS_BYTES, stream);
  if (e != hipSuccess) fprintf(stderr, "cooperative launch failed: %s (grid %d)\n", hipGetErrorString(e), grid_blocks);
}
```

```cpp
#include <hip/hip_runtime.h>
#include <hip/hip_cooperative_groups.h>
#include <cstdio>
namespace cg = cooperative_groups;

typedef __attribute__((ext_vector_type(8))) short bf16x8;
typedef __attribute__((ext_vector_type(4))) float f32x4;
typedef __attribute__((ext_vector_type(16))) float f32x16;
typedef __attribute__((ext_vector_type(2))) __bf16 bf2_t;
typedef unsigned short u16;

#define DEV __device__ __forceinline__

constexpr int NTOK_P = 32768;
constexpr int NTOK = 32896;
constexpr size_t NP = 33554432, NS = 131072;
constexpr size_t OFF_K0P = NP + NS, OFF_V0P = 2 * NP + NS, OFF_K0S = 3 * NP + NS, OFF_V0S = 3 * NP + 2 * NS;
constexpr size_t OFF_K1P = 3 * NP + 3 * NS, OFF_V1P = 4 * NP + 3 * NS, OFF_K1S = 5 * NP + 3 * NS, OFF_V1S = 5 * NP + 4 * NS;

constexpr size_t WS_WT_IN0 = 0;
constexpr size_t WS_WT_OUT0 = 8388608;
constexpr size_t WS_WT_IN1 = 10485760;
constexpr size_t WS_WT_OUT1 = 18874368;
constexpr size_t WS_ACT = 20971520;
constexpr size_t WS_SG = WS_ACT + 67371008;
constexpr size_t WS_QF = WS_SG + 67371008;
constexpr size_t WS_KF = WS_QF + 67108864;
constexpr size_t WS_VF = WS_KF + 67108864;
constexpr size_t WS_QFS = WS_VF + 67108864;
constexpr size_t WS_KFS = WS_QFS + 524288;
constexpr size_t WS_VFS = WS_KFS + 524288;
constexpr size_t WS_CNT = WS_VFS + 524288;
constexpr size_t WS_BAR = WS_CNT + 256;
constexpr int LDS_BYTES = 131072 + 18432;
constexpr float LOG2E = 1.4426950408889634f;

struct Params {
  const float* x_prompt; const float* x_sample;
  const float* ck0; const float* cv0; const float* ck1; const float* cv1;
  const float* norm_g0; const float* w_in0; const float* q_norm; const float* k_norm;
  const float* lq1; const float* lk1; const float* lq2; const float* lk2;
  const float* subln_g; const float* w_out0; const float* norm_g1; const float* w_in1; const float* w_out1;
  float* out;
  char* ws;
};

DEV unsigned pk2(float a, float b) { bf2_t v; v[0] = (__bf16)a; v[1] = (__bf16)b; return __builtin_bit_cast(unsigned, v); }
DEV u16 f2bf(float a) { __bf16 v = (__bf16)a; return __builtin_bit_cast(u16, v); }
DEV float bflo(unsigned v) { return __uint_as_float(v << 16); }
DEV float bfhi(unsigned v) { return __uint_as_float(v & 0xffff0000u); }
DEV bf16x8 mk8(unsigned a, unsigned b, unsigned c, unsigned d) { uint4 q = make_uint4(a, b, c, d); return __builtin_bit_cast(bf16x8, q); }
DEV float wave_sum(float v) {
#pragma unroll
  for (int o = 32; o; o >>= 1) v += __shfl_xor(v, o);
  return v;
}
DEV int opaque_tid() { int t = threadIdx.x; asm volatile("" : "+v"(t)); return t; }
DEV float ex2(float x) { return __builtin_amdgcn_exp2f(x); }
DEV float lg2(float x) { return __builtin_amdgcn_logf(x); }

typedef __attribute__((ext_vector_type(4))) unsigned u32x4_t;
DEV void nt_store_u4(void* ptr, uint4 v) { u32x4_t q = {v.x, v.y, v.z, v.w}; __builtin_nontemporal_store(q, (u32x4_t*)ptr); }
DEV void nt_store_f4(void* ptr, f32x4 v) { __builtin_nontemporal_store(v, (f32x4*)ptr); }

namespace pg8 {
#define PG8_LAS __attribute__((address_space(3)))
constexpr int BM = 256, BK = 64, HALF = 128, HTB = HALF * BK * 2, STAGE_BYTES = 8 * HTB, NXCD = 8, WGM = 8;
__device__ __forceinline__ int lds_byte(int r, int c) { const int st = (r >> 4) * 2 + (c >> 5), rr = r & 15, cc = c & 31, ob = rr * 64 + cc * 2; return st * 1024 + (ob ^ (((ob >> 9) & 1) << 5)); }
__device__ __forceinline__ void stage_rc(int b, int& R, int& C) { const int st = b / 1024, sb = b % 1024, swz = sb ^ (((sb >> 9) & 1) << 5); R = (st >> 1) * 16 + swz / 64; C = (st & 1) * 32 + (swz % 64) / 2; }
struct Unit { int pm, pn; };
struct Gemm { const u16* A; const u16* Bt; int M, N, K; };
struct StaticOrder {
  int nM, nN, nwg, G, c;
  __device__ void init(int M, int N, int G_, int c_) { nM = M / BM; nN = N / BM; nwg = nM * nN; G = G_; c = c_; }
  __device__ bool next(int i, Unit& u) const {
    const long L = (long)i * G + c; if (L >= nwg) return false;
    int wgid = (int)L; { const int q = nwg / NXCD, r = nwg % NXCD, xcd = wgid % NXCD, off = wgid / NXCD; wgid = (xcd < r ? xcd * (q + 1) : r * (q + 1) + (xcd - r) * q) + off; }
    const int nig = WGM * nN, gid = wgid / nig, fm = gid * WGM, gsz = (nM - fm) < WGM ? (nM - fm) : WGM;
    u.pm = fm + ((wgid % nig) % gsz); u.pn = (wgid % nig) / gsz; return true;
  }
};
template <class Epi>
__device__ __forceinline__ void gemm_phase(PG8_LAS unsigned char* lds, const Gemm g, const StaticOrder& S, const Epi& E) {
  const int tid = opaque_tid(), wid = __builtin_amdgcn_readfirstlane(tid >> 6), lane = tid & 63, wr = wid >> 2, wc = wid & 3, fr = lane & 15, fq = lane >> 4;
  const int K = g.K, nt = K / BK;
  unsigned voffA[2], voffB[2];
#pragma unroll
  for (int i = 0; i < 2; ++i) { int R, C; stage_rc(tid * 16 + i * 8192, R, C); const int Rb = ((R >> 5) << 6) + (R & 31);
    voffA[i] = (unsigned)(R * K + C) * 2u; voffB[i] = (unsigned)(Rb * K + C) * 2u; }
  const size_t kstep = (size_t)(BK * 2);
  const size_t hstep = (size_t)HALF * K * 2;
  const size_t hstepB = (size_t)32 * K * 2;
  const size_t tstep = 2 * hstep;
  const unsigned ldsw = (unsigned)wid * 1024u;
  const int aoff = lds_byte(wr * 64 + fr, fq * 8), boff = lds_byte(wc * 32 + fr, fq * 8);
#define PG8_SA(b, h) (((b) * 2 + (h)) * HTB)
#define PG8_SB(b, h) ((4 + (b) * 2 + (h)) * HTB)
#define PG8_STAGE(bufoff, gbase, voff) do { _Pragma("unroll") for (int _i = 0; _i < 2; ++_i) \
    __builtin_amdgcn_global_load_lds((const __attribute__((address_space(1))) unsigned*)((const char*)(gbase) + (voff)[_i]), (PG8_LAS unsigned*)(lds + (bufoff) + ldsw + _i * 8192), 16, 0, 0); } while (0)
#define PG8_LDA(dst, b, h) do { _Pragma("unroll") for (int m = 0; m < 4; ++m) _Pragma("unroll") for (int k = 0; k < 2; ++k) dst[m][k] = *(const PG8_LAS bf16x8*)(lds + PG8_SA(b, h) + aoff + m * 2048 + k * 1024); } while (0)
#define PG8_LDB(dst, b, h) do { _Pragma("unroll") for (int n = 0; n < 2; ++n) _Pragma("unroll") for (int k = 0; k < 2; ++k) dst[n][k] = *(const PG8_LAS bf16x8*)(lds + PG8_SB(b, h) + boff + n * 2048 + k * 1024); } while (0)
#define PG8_MMA(ai, bj, At, Bt) do { __builtin_amdgcn_s_setprio(1); _Pragma("unroll") for (int m = 0; m < 4; ++m) _Pragma("unroll") for (int n = 0; n < 2; ++n) _Pragma("unroll") for (int k = 0; k < 2; ++k) \
    acc[ai][bj][m][n] = __builtin_amdgcn_mfma_f32_16x16x32_bf16(Bt[n][k], At[m][k], acc[ai][bj][m][n], 0, 0, 0); __builtin_amdgcn_s_setprio(0); } while (0)
#define PG8_WAIT_V(n) asm volatile("s_waitcnt vmcnt(" #n ")" ::: "memory")
#define PG8_WAIT_L(n) asm volatile("s_waitcnt lgkmcnt(" #n ")" ::: "memory")
#define PG8_BAR __builtin_amdgcn_s_barrier()
#define PG8_SCHED __builtin_amdgcn_sched_barrier(0)
  Unit cur, nxt; int ui = 0;
  if (!S.next(0, cur)) return;
  f32x4 acc[2][2][4][2];
#pragma unroll
  for (int a = 0; a < 2; ++a)
#pragma unroll
    for (int b = 0; b < 2; ++b)
#pragma unroll
      for (int m = 0; m < 4; ++m)
#pragma unroll
        for (int n = 0; n < 2; ++n) acc[a][b][m][n] = (f32x4){0.f, 0.f, 0.f, 0.f};
  bf16x8 At[4][2], B0[2][2], B1[2][2];
  const char* cA = (const char*)g.A + (size_t)cur.pm * tstep; const char* cB = (const char*)g.Bt + (size_t)cur.pn * tstep;
  PG8_STAGE(PG8_SB(0, 0), cB, voffB); PG8_STAGE(PG8_SA(0, 0), cA, voffA); PG8_STAGE(PG8_SB(0, 1), cB + hstepB, voffB); PG8_STAGE(PG8_SA(0, 1), cA + hstep, voffA);
  if (wr == 1) PG8_BAR;
  PG8_WAIT_V(4); PG8_BAR;
  PG8_STAGE(PG8_SB(1, 0), cB + kstep, voffB); PG8_STAGE(PG8_SA(1, 0), cA + kstep, voffA); PG8_STAGE(PG8_SB(1, 1), cB + hstepB + kstep, voffB);
  PG8_WAIT_V(6); PG8_BAR;
  for (;;) {
    const bool has_next = S.next(ui + 1, nxt);
    const char* nA = has_next ? (const char*)g.A + (size_t)nxt.pm * tstep : cA; const char* nB = has_next ? (const char*)g.Bt + (size_t)nxt.pn * tstep : cB;
    for (int t = 0; t < nt; t += 2) {
      const bool last = (t == nt - 2);
      const char* a1 = cA + (size_t)(t + 1) * kstep;
      const char* a2 = last ? nA : cA + (size_t)(t + 2) * kstep; const char* b2 = last ? nB : cB + (size_t)(t + 2) * kstep;
      const char* a3 = a2 + kstep; const char* b3 = b2 + kstep;
      PG8_LDB(B0, 0, 0); PG8_SCHED; PG8_LDA(At, 0, 0); PG8_STAGE(PG8_SA(1, 1), a1 + hstep, voffA);
      PG8_WAIT_L(8); PG8_BAR; PG8_WAIT_L(0); PG8_MMA(0, 0, At, B0); PG8_BAR; PG8_SCHED;
      PG8_LDB(B1, 0, 1); PG8_STAGE(PG8_SB(0, 0), b2, voffB);
      PG8_BAR; PG8_WAIT_L(0); PG8_MMA(0, 1, At, B1); PG8_BAR;
      PG8_LDA(At, 0, 1); PG8_STAGE(PG8_SA(0, 0), a2, voffA);
      PG8_BAR; PG8_WAIT_L(0); PG8_MMA(1, 0, At, B0); PG8_BAR; PG8_SCHED;
      PG8_STAGE(PG8_SB(0, 1), b2 + hstepB, voffB);
      PG8_WAIT_V(6); PG8_BAR; PG8_MMA(1, 1, At, B1); PG8_BAR;
      PG8_LDB(B0, 1, 0); PG8_SCHED; PG8_LDA(At, 1, 0); PG8_STAGE(PG8_SA(0, 1), a2 + hstep, voffA);
      PG8_WAIT_L(8); PG8_BAR; PG8_WAIT_L(0); PG8_MMA(0, 0, At, B0); PG8_BAR; PG8_SCHED;
      PG8_LDB(B1, 1, 1); PG8_STAGE(PG8_SB(1, 0), b3, voffB);
      PG8_BAR; PG8_WAIT_L(0); PG8_MMA(0, 1, At, B1); PG8_BAR;
      PG8_LDA(At, 1, 1); PG8_STAGE(PG8_SA(1, 0), a3, voffA);
      PG8_BAR; PG8_WAIT_L(0); PG8_MMA(1, 0, At, B0); PG8_BAR; PG8_SCHED;
      PG8_STAGE(PG8_SB(1, 1), b3 + hstepB, voffB);
      PG8_WAIT_V(6); PG8_BAR; PG8_MMA(1, 1, At, B1); PG8_BAR;
    }
    E(acc, cur, wr, wc, fr, fq);
    if (!has_next) break;
#pragma unroll
    for (int a = 0; a < 2; ++a)
#pragma unroll
      for (int b = 0; b < 2; ++b)
#pragma unroll
        for (int m = 0; m < 4; ++m)
#pragma unroll
          for (int n = 0; n < 2; ++n) acc[a][b][m][n] = (f32x4){0.f, 0.f, 0.f, 0.f};
    cur = nxt; cA = nA; cB = nB; ++ui;
  }
  PG8_WAIT_V(0);
  if (wr == 0) PG8_BAR;
  PG8_BAR;
#undef PG8_SA
#undef PG8_SB
#undef PG8_STAGE
#undef PG8_LDA
#undef PG8_LDB
#undef PG8_MMA
#undef PG8_WAIT_V
#undef PG8_WAIT_L
#undef PG8_BAR
#undef PG8_SCHED
}
}

template <int LAYER>
struct EpiIn {
  Params p; char* xl;
  DEV void operator()(const f32x4 (&acc)[2][2][4][2], const pg8::Unit& u, int wr, int wc, int fr, int fq) const {
    const int lane = fq * 16 + fr;
    const int nb = u.pn * 256 + wc * 64;
    const int region = nb >> 10, f0 = nb & 1023, hc = f0 >> 6;
    char* ws = p.ws;
    u16* vl = (u16*)(xl + (wr * 4 + wc) * 2304);
#pragma unroll
    for (int ai = 0; ai < 2; ++ai) {
      const int tb = u.pm * 256 + ai * 128 + wr * 64;
      if (region <= 1) {
        const float* gn = (region == 0) ? p.q_norm : p.k_norm;
#pragma unroll
        for (int m = 0; m < 4; ++m) {
          const int t = tb + m * 16 + fr;
          const int b = t >> 11, s = t & 2047;
          float rinv = 1.f;
          if (LAYER == 0) {
            float ss = 0.f;
#pragma unroll
            for (int bj = 0; bj < 2; ++bj)
#pragma unroll
              for (int n = 0; n < 2; ++n)
#pragma unroll
                for (int j = 0; j < 4; ++j) ss += acc[ai][bj][m][n][j] * acc[ai][bj][m][n][j];
            ss += __shfl_xor(ss, 16);
            ss += __shfl_xor(ss, 32);
            rinv = rsqrtf(ss * (1.f / 64.f) + 1e-6f);
          }
          u16* fb = (u16*)(ws + (region == 0 ? WS_QF : WS_KF)) + ((size_t)(b * 16 + hc) * 64 + (s >> 5)) * 2048 + ((fq >> 1) * 32 + (s & 31)) * 8 + (fq & 1) * 4;
          float* ko = p.out + (LAYER == 0 ? OFF_K0P : OFF_K1P) + (size_t)t * 1024 + f0 + 4 * fq;
#pragma unroll
          for (int bj = 0; bj < 2; ++bj)
#pragma unroll
            for (int n = 0; n < 2; ++n) {
              f32x4 v = acc[ai][bj][m][n];
              if (LAYER == 0) {
                const f32x4 g4 = *(const f32x4*)(gn + 32 * bj + 16 * n + 4 * fq);
                v = v * g4 * rinv;
              }
              if (region == 1) nt_store_f4(ko + 32 * bj + 16 * n, v);
              if (region == 0) v = v * (0.125f * LOG2E);
              uint2 pk;
              pk.x = pk2(v[0], v[1]);
              pk.y = pk2(v[2], v[3]);
              *(uint2*)(fb + (2 * bj + n) * 512) = pk;
            }
        }
      } else if (region == 2) {
#pragma unroll
        for (int m = 0; m < 4; ++m) {
          float* vo = p.out + (LAYER == 0 ? OFF_V0P : OFF_V1P) + (size_t)(tb + m * 16 + fr) * 1024 + f0 + 4 * fq;
#pragma unroll
          for (int bj = 0; bj < 2; ++bj)
#pragma unroll
            for (int n = 0; n < 2; ++n) nt_store_f4(vo + 32 * bj + 16 * n, acc[ai][bj][m][n]);
        }
        const int r = lane & 31, hh = lane >> 5;
#pragma unroll
        for (int mp = 0; mp < 2; ++mp) {
          const int tk = tb + mp * 32;
          const int b = tk >> 11, tile = (tk & 2047) >> 5;
#pragma unroll
          for (int bj = 0; bj < 2; ++bj) {
#pragma unroll
            for (int mm = 0; mm < 2; ++mm)
#pragma unroll
              for (int n = 0; n < 2; ++n)
#pragma unroll
                for (int j = 0; j < 4; ++j) vl[(16 * n + 4 * fq + j) * 36 + mm * 16 + fr] = f2bf(acc[ai][bj][2 * mp + mm][n][j]);
            u16* vb;
            if (LAYER == 0) vb = (u16*)(ws + WS_VF) + ((size_t)(b * 8 + (f0 >> 7)) * 64 + tile) * 4096 + ((((f0 & 127) >> 5) + bj) * 2) * 512 + lane * 8;
            else            vb = (u16*)(ws + WS_VF) + ((size_t)(b * 16 + hc) * 64 + tile) * 2048 + (bj * 2) * 512 + lane * 8;
#pragma unroll
            for (int sv = 0; sv < 2; ++sv) {
              const uint2 lo = *(const uint2*)(vl + r * 36 + 16 * sv + 4 * hh);
              const uint2 hi = *(const uint2*)(vl + r * 36 + 16 * sv + 8 + 4 * hh);
              *(uint4*)(vb + sv * 512) = make_uint4(lo.x, lo.y, hi.x, hi.y);
            }
          }
        }
      } else {
#pragma unroll
        for (int m = 0; m < 4; ++m) {
          u16* sg = (u16*)(ws + WS_SG) + (size_t)(tb + m * 16 + fr) * 1024 + f0 + 4 * fq;
#pragma unroll
          for (int bj = 0; bj < 2; ++bj)
#pragma unroll
            for (int n = 0; n < 2; ++n) {
              float v[4];
#pragma unroll
              for (int j = 0; j < 4; ++j) { const float x = acc[ai][bj][m][n][j]; v[j] = x * __builtin_amdgcn_rcpf(1.f + __expf(-x)); }
              uint2 pk;
              pk.x = pk2(v[0], v[1]);
              pk.y = pk2(v[2], v[3]);
              *(uint2*)(sg + 32 * bj + 16 * n) = pk;
            }
        }
      }
    }
  }
};

template <int LAYER>
struct EpiOut {
  Params p;
  DEV void operator()(const f32x4 (&acc)[2][2][4][2], const pg8::Unit& u, int wr, int wc, int fr, int fq) const {
    const int col = u.pn * 256 + wc * 64 + 4 * fq;
    const size_t t0 = (size_t)(u.pm * 256 + wr * 64 + fr);
    f32x4 xr[3][4];
    auto rowp = [&](int g) { return (size_t)(t0 + (g >> 2) * 128 + (g & 3) * 16) * 1024 + col; };
    auto ldg = [&](int g, f32x4 (&x)[4]) {
      const float* xi = ((LAYER == 0) ? p.x_prompt : (const float*)p.out) + rowp(g);
#pragma unroll
      for (int q = 0; q < 4; ++q) x[q] = *(const f32x4*)(xi + 32 * (q >> 1) + 16 * (q & 1));
    };
    ldg(0, xr[0]);
    ldg(1, xr[1]);
#pragma unroll
    for (int g = 0; g < 8; ++g) {
      if (g + 2 < 8) ldg(g + 2, xr[(g + 2) % 3]);
      float* yo = p.out + rowp(g);
#pragma unroll
      for (int q = 0; q < 4; ++q) *(f32x4*)(yo + 32 * (q >> 1) + 16 * (q & 1)) = xr[g % 3][q] + acc[g >> 2][q >> 1][g & 3][q & 1];
    }
  }
};

DEV void gemm_tile(const u16* __restrict__ Wt, const u16* __restrict__ X, int n0, int m0, char* lds, f32x4 (&acc)[4][2]) {
  const int tid = opaque_tid(), lane = tid & 63, w = tid >> 6;
  const int wa = w & 1, wb = w >> 1;
  const int lr = lane & 15, lq = lane >> 4;
  const int srow = tid >> 3, skc = (tid & 7) ^ (srow & 7);
  const u16* ga = Wt + (size_t)(n0 + srow) * 1024 + skc * 8;
  const u16* gb = X + (size_t)(m0 + srow) * 1024 + skc * 8;
  typedef __attribute__((address_space(3))) unsigned lds_u32;
  typedef const __attribute__((address_space(1))) unsigned glb_u32;
#define GLDS(gp, lp) __builtin_amdgcn_global_load_lds((glb_u32*)(gp), (lds_u32*)(lp), 16, 0, 0)
#define GT_STAGE(kt) do { char* d_ = sdst + ((kt) & 3) * 32768; const int ko_ = (kt) * 64; \
    GLDS(ga + ko_, d_); GLDS(ga + (size_t)64 * 1024 + ko_, d_ + 8192); \
    GLDS(gb + ko_, d_ + 16384); GLDS(gb + (size_t)64 * 1024 + ko_, d_ + 16384 + 8192); } while (0)
#pragma unroll
  for (int mt = 0; mt < 4; ++mt)
#pragma unroll
    for (int nt = 0; nt < 2; ++nt) acc[mt][nt] = f32x4{0.f, 0.f, 0.f, 0.f};
  char* sdst = lds + tid * 16;
  __syncthreads();
  GT_STAGE(0); GT_STAGE(1); GT_STAGE(2);
  const int aoff = (wa * 64 + lr) * 128;
  const int boff = 16384 + (wb * 32 + lr) * 128;
  const int sw = lr & 7;
  for (int kt = 0; kt < 16; ++kt) {
    if (kt + 2 < 16) asm volatile("s_waitcnt vmcnt(8) lgkmcnt(0)" ::: "memory");
    else if (kt + 1 < 16) asm volatile("s_waitcnt vmcnt(4) lgkmcnt(0)" ::: "memory");
    else asm volatile("s_waitcnt vmcnt(0) lgkmcnt(0)" ::: "memory");
    __builtin_amdgcn_s_barrier();
    asm volatile("" ::: "memory");
    if (kt + 3 < 16) GT_STAGE(kt + 3);
    const char* cur = lds + (kt & 3) * 32768;
#pragma unroll
    for (int kk = 0; kk < 2; ++kk) {
      bf16x8 a[4], b[2];
      const int co = ((kk * 4 + lq) ^ sw) << 4;
#pragma unroll
      for (int mt = 0; mt < 4; ++mt) a[mt] = *(const bf16x8*)(cur + aoff + mt * 2048 + co);
#pragma unroll
      for (int nt = 0; nt < 2; ++nt) b[nt] = *(const bf16x8*)(cur + boff + nt * 2048 + co);
#pragma unroll
      for (int mt = 0; mt < 4; ++mt)
#pragma unroll
        for (int nt = 0; nt < 2; ++nt)
          acc[mt][nt] = __builtin_amdgcn_mfma_f32_16x16x32_bf16(a[mt], b[nt], acc[mt][nt], 0, 0, 0);
    }
  }
  __syncthreads();
#undef GLDS
#undef GT_STAGE
}

template <int LAYER>
DEV void inproj_epilogue(const Params& p, f32x4 (&acc)[4][2], int n0, int m0) {
  const int tid = opaque_tid(), lane = tid & 63, w = tid >> 6;
  const int wa = w & 1, wb = w >> 1;
  const int lr = lane & 15, lq = lane >> 4;
  const int region = n0 >> 10;
  const int f0 = (n0 & 1023) + wa * 64;
  const int hc = f0 >> 6;
  char* ws = p.ws;
#pragma unroll
  for (int nt = 0; nt < 2; ++nt) {
    const int t = m0 + wb * 32 + nt * 16 + lr;
    const bool samp = t >= NTOK_P;
    const int ts = t - NTOK_P;
    const int b = samp ? (ts >> 4) : (t >> 11);
    const int s = samp ? (ts & 15) : (t & 2047);
    if (region <= 1) {
      float rinv = 1.f;
      if (LAYER == 0) {
        float ss = 0.f;
#pragma unroll
        for (int mt = 0; mt < 4; ++mt)
#pragma unroll
          for (int j = 0; j < 4; ++j) ss += acc[mt][nt][j] * acc[mt][nt][j];
        ss += __shfl_xor(ss, 16);
        ss += __shfl_xor(ss, 32);
        rinv = rsqrtf(ss * (1.f / 64.f) + 1e-6f);
      }
      const float qscale = (region == 0) ? (0.125f * LOG2E) : 1.f;
      const float* gn = (region == 0) ? p.q_norm : p.k_norm;
      u16* fb;
      if (region == 0)
        fb = samp ? (u16*)(ws + WS_QFS) + (size_t)(b * 16 + hc) * 2048
                  : (u16*)(ws + WS_QF) + ((size_t)(b * 16 + hc) * 64 + (s >> 5)) * 2048;
      else
        fb = samp ? (u16*)(ws + WS_KFS) + (size_t)(b * 16 + hc) * 2048
                  : (u16*)(ws + WS_KF) + ((size_t)(b * 16 + hc) * 64 + (s >> 5)) * 2048;
      const int rr = samp ? s : (s & 31);
      float* kout = nullptr;
      if (region == 1) {
        if (LAYER == 0) kout = p.out + (samp ? OFF_K0S + (size_t)ts * 1024 : OFF_K0P + (size_t)t * 1024) + f0;
        else            kout = p.out + (samp ? OFF_K1S + (size_t)ts * 1024 : OFF_K1P + (size_t)t * 1024) + f0;
      }
#pragma unroll
      for (int mt = 0; mt < 4; ++mt) {
        float v[4];
        if (LAYER == 0) {
          const float4 g4 = *(const float4*)(gn + mt * 16 + lq * 4);
          v[0] = acc[mt][nt][0] * rinv * g4.x; v[1] = acc[mt][nt][1] * rinv * g4.y;
          v[2] = acc[mt][nt][2] * rinv * g4.z; v[3] = acc[mt][nt][3] * rinv * g4.w;
        } else {
#pragma unroll
          for (int j = 0; j < 4; ++j) v[j] = acc[mt][nt][j];
        }
        if (region == 1) *(float4*)(kout + mt * 16 + lq * 4) = make_float4(v[0], v[1], v[2], v[3]);
        uint2 pk;
        pk.x = pk2(v[0] * qscale, v[1] * qscale);
        pk.y = pk2(v[2] * qscale, v[3] * qscale);
        *(uint2*)(fb + (mt * 64 + (lq >> 1) * 32 + rr) * 8 + (lq & 1) * 4) = pk;
      }
    } else if (region == 2) {
      float* vout;
      if (LAYER == 0) vout = p.out + (samp ? OFF_V0S + (size_t)ts * 1024 : OFF_V0P + (size_t)t * 1024) + f0;
      else            vout = p.out + (samp ? OFF_V1S + (size_t)ts * 1024 : OFF_V1P + (size_t)t * 1024) + f0;
      const int kk = samp ? s : (s & 31);
      const int sv = kk >> 4, hh = (kk >> 2) & 1, jf = ((kk >> 3) & 1) * 4 + (kk & 3);
      u16* vb;
      int dbase;
      if (LAYER == 0) {
        const int h = f0 >> 7;
        dbase = f0 & 127;
        vb = samp ? (u16*)(ws + WS_VFS) + (size_t)(b * 8 + h) * 4096
                  : (u16*)(ws + WS_VF) + ((size_t)(b * 8 + h) * 64 + (s >> 5)) * 4096;
      } else {
        dbase = 0;
        vb = samp ? (u16*)(ws + WS_VFS) + (size_t)(b * 16 + hc) * 2048
                  : (u16*)(ws + WS_VF) + ((size_t)(b * 16 + hc) * 64 + (s >> 5)) * 2048;
      }
#pragma unroll
      for (int mt = 0; mt < 4; ++mt) {
        *(float4*)(vout + mt * 16 + lq * 4) = make_float4(acc[mt][nt][0], acc[mt][nt][1], acc[mt][nt][2], acc[mt][nt][3]);
#pragma unroll
        for (int j = 0; j < 4; ++j) {
          const int d = dbase + mt * 16 + lq * 4 + j;
          vb[((d >> 5) * 2 + sv) * 512 + (hh * 32 + (d & 31)) * 8 + jf] = f2bf(acc[mt][nt][j]);
        }
      }
    } else {
      u16* sg = (u16*)(ws + WS_SG) + (size_t)t * 1024 + f0;
#pragma unroll
      for (int mt = 0; mt < 4; ++mt) {
        float v[4];
#pragma unroll
        for (int j = 0; j < 4; ++j) {
          const float x = acc[mt][nt][j];
          v[j] = x * __builtin_amdgcn_rcpf(1.f + __expf(-x));
        }
        uint2 pk;
        pk.x = pk2(v[0], v[1]);
        pk.y = pk2(v[2], v[3]);
        *(uint2*)(sg + mt * 16 + lq * 4) = pk;
      }
    }
  }
}

template <int LAYER>
DEV void outproj_epilogue(const Params& p, f32x4 (&acc)[4][2], int n0, int m0) {
  const int tid = opaque_tid(), lane = tid & 63, w = tid >> 6;
  const int wa = w & 1, wb = w >> 1;
  const int lr = lane & 15, lq = lane >> 4;
#pragma unroll
  for (int nt = 0; nt < 2; ++nt) {
    const int t = m0 + wb * 32 + nt * 16 + lr;
    float* yo = p.out + (size_t)t * 1024 + n0 + wa * 64 + lq * 4;
    const float* xi;
    if (LAYER == 0)
      xi = (t >= NTOK_P ? p.x_sample + (size_t)(t - NTOK_P) * 1024 : p.x_prompt + (size_t)t * 1024) + n0 + wa * 64 + lq * 4;
    else
      xi = yo;
#pragma unroll
    for (int mt = 0; mt < 4; ++mt) {
      const float4 xv = *(const float4*)(xi + mt * 16);
      *(float4*)(yo + mt * 16) = make_float4(xv.x + acc[mt][nt][0], xv.y + acc[mt][nt][1], xv.z + acc[mt][nt][2], xv.w + acc[mt][nt][3]);
    }
  }
}

DEV void transpose_tile(const float* __restrict__ W, int N, u16* __restrict__ Wt, int k0, int n0, float* ldsf) {
  const int tid = opaque_tid();
#pragma unroll
  for (int i = 0; i < 2; ++i) {
    const int idx = tid + 512 * i;
    const int kr = idx >> 4, c4 = idx & 15;
    const float4 v = *(const float4*)(W + (size_t)(k0 + kr) * N + n0 + c4 * 4);
    float* d = ldsf + kr * 65 + c4 * 4;
    d[0] = v.x; d[1] = v.y; d[2] = v.z; d[3] = v.w;
  }
  __syncthreads();
  {
    const int n = tid >> 3, kc = tid & 7;
    float f[8];
#pragma unroll
    for (int j = 0; j < 8; ++j) f[j] = ldsf[(kc * 8 + j) * 65 + n];
    uint4 o = make_uint4(pk2(f[0], f[1]), pk2(f[2], f[3]), pk2(f[4], f[5]), pk2(f[6], f[7]));
    *(uint4*)(Wt + (size_t)(n0 + n) * 1024 + k0 + kc * 8) = o;
  }
  __syncthreads();
}

template <class SrcOf>
DEV void norm_rows(SrcOf src_of, const float* __restrict__ g, u16* __restrict__ dst, int row0, int stride, int lane) {
  float4 cur[4], nxt[4];
  if (row0 < NTOK) {
    const float4* s = (const float4*)src_of(row0);
#pragma unroll
    for (int i = 0; i < 4; ++i) cur[i] = s[lane + 64 * i];
  }
  for (int row = row0; row < NTOK; row += stride) {
    const int nr = row + stride;
    if (nr < NTOK) {
      const float4* s = (const float4*)src_of(nr);
#pragma unroll
      for (int i = 0; i < 4; ++i) nxt[i] = s[lane + 64 * i];
    }
    float ss = 0.f;
#pragma unroll
    for (int i = 0; i < 4; ++i) ss += cur[i].x * cur[i].x + cur[i].y * cur[i].y + cur[i].z * cur[i].z + cur[i].w * cur[i].w;
    ss = wave_sum(ss);
    const float rn = rsqrtf(ss * (1.f / 1024.f) + 1e-6f);
    uint2* d = (uint2*)(dst + (size_t)row * 1024);
#pragma unroll
    for (int i = 0; i < 4; ++i) {
      const float4 gg = ((const float4*)g)[lane + 64 * i];
      uint2 o;
      o.x = pk2(cur[i].x * rn * gg.x, cur[i].y * rn * gg.y);
      o.y = pk2(cur[i].z * rn * gg.z, cur[i].w * rn * gg.w);
      d[lane + 64 * i] = o;
    }
#pragma unroll
    for (int i = 0; i < 4; ++i) cur[i] = nxt[i];
  }
}

DEV void attn0_ptile(const f32x16& S, float base, float slope2, bool first_half_only, float& l, unsigned (&pw)[8]) {
#pragma unroll
  for (int i = 0; i < 16; i += 2) {
    const float ca = (float)((i & 3) + 8 * (i >> 2));
    const float cb = (float)(((i + 1) & 3) + 8 * ((i + 1) >> 2));
    float ea = ex2(fmaf(-slope2, fabsf(base - ca), S[i]));
    float eb = ex2(fmaf(-slope2, fabsf(base - cb), S[i + 1]));
    if (first_half_only && i >= 8) { ea = 0.f; eb = 0.f; }
    l += ea + eb;
    pw[i >> 1] = pk2(ea, eb);
  }
}

DEV void attn0_gate_load(const Params& p, size_t t, int h, int hh, uint2 (&gt)[4][4]) {
  const u16* sgp = (const u16*)(p.ws + WS_SG) + t * 1024 + h * 128;
#pragma unroll
  for (int db = 0; db < 4; ++db)
#pragma unroll
    for (int g = 0; g < 4; ++g) gt[db][g] = *(const uint2*)(sgp + db * 32 + 8 * g + 4 * hh);
}
DEV void attn0_finish(const Params& p, f32x16 (&O)[4], size_t t, int h, int hh, bool valid, const uint2 (&gtp)[4][4]) {
  float ss = 0.f;
#pragma unroll
  for (int db = 0; db < 4; ++db)
#pragma unroll
    for (int i = 0; i < 16; ++i) ss += O[db][i] * O[db][i];
  ss += __shfl_xor(ss, 32);
  const float rn = rsqrtf(ss * (1.f / 128.f) + 1e-6f) * 0.8f;
  if (valid) {
    u16* ogp = (u16*)(p.ws + WS_ACT) + t * 1024 + h * 128;
#pragma unroll
    for (int db = 0; db < 4; ++db)
#pragma unroll
      for (int g = 0; g < 4; ++g) {
        const int d = db * 32 + 8 * g + 4 * hh;
        const float4 gn = *(const float4*)(p.subln_g + d);
        const uint2 gt = gtp[db][g];
        uint2 o;
        o.x = pk2(O[db][4 * g + 0] * rn * gn.x * bflo(gt.x), O[db][4 * g + 1] * rn * gn.y * bfhi(gt.x));
        o.y = pk2(O[db][4 * g + 2] * rn * gn.z * bflo(gt.y), O[db][4 * g + 3] * rn * gn.w * bfhi(gt.y));
        *(uint2*)(ogp + d) = o;
      }
  }
}

DEV void attn0_prompt(const Params& p, int b, int h, int cp, int kt0, char* lds, int lane, int w, float neg_lam) {
  const int pair = w >> 1, comp = w & 1;
  const int r = lane & 31, hh = lane >> 5;
  const int qblk = 4 * cp + pair;
  const int my_nt = 2 * ((qblk >> 1) + 1);
  const int NT = 4 * cp + 4;
  char* ws = p.ws;
  typedef __attribute__((address_space(3))) unsigned lds_u32;
  typedef const __attribute__((address_space(1))) unsigned glb_u32;
  char* qst = lds + 65536 + w * 8192 + lane * 16;
  {
    const u16* qb = (const u16*)(ws + WS_QF) + ((size_t)(b * 16 + 2 * h + comp) * 64 + qblk) * 2048 + lane * 8;
#pragma unroll
    for (int s = 0; s < 4; ++s) __builtin_amdgcn_global_load_lds((glb_u32*)(qb + s * 512), (lds_u32*)(qst + s * 1024), 16, 0, 0);
  }
  const u16* src0;
  size_t tstride;
  if (w < 4) { src0 = (const u16*)(ws + WS_KF) + (size_t)(b * 16 + 2 * h + (w >> 1)) * 64 * 2048 + ((2 * w) & 3) * 512 + lane * 8; tstride = 2048; }
  else       { src0 = (const u16*)(ws + WS_VF) + (size_t)(b * 8 + h) * 64 * 4096 + (2 * w - 8) * 512 + lane * 8; tstride = 4096; }
  char* dst0 = lds + (2 * w) * 1024 + lane * 16;
#define ATT_DMA(kt) do { const u16* s_ = src0 + (size_t)(kt) * tstride; char* d_ = dst0 + ((kt) & 3) * 16384; \
    __builtin_amdgcn_global_load_lds((glb_u32*)s_, (lds_u32*)d_, 16, 0, 0); \
    __builtin_amdgcn_global_load_lds((glb_u32*)(s_ + 512), (lds_u32*)(d_ + 1024), 16, 0, 0); } while (0)
  ATT_DMA(kt0); ATT_DMA(kt0 + 1); ATT_DMA(kt0 + 2);
  asm volatile("s_waitcnt vmcnt(6)" ::: "memory");
  bf16x8 qf[4];
#pragma unroll
  for (int s = 0; s < 4; ++s) qf[s] = *(const bf16x8*)(qst + s * 1024);
  f32x16 O[4];
#pragma unroll
  for (int db = 0; db < 4; ++db)
#pragma unroll
    for (int i = 0; i < 16; ++i) O[db][i] = 0.f;
  float l = 0.f;
  const float slope2 = exp2f(-(float)(h + 1)) * LOG2E;
  const float qposf = (float)(qblk * 32 + r);
  for (int kt = kt0; kt < NT; ++kt) {
    if (kt + 2 < NT) asm volatile("s_waitcnt vmcnt(4) lgkmcnt(0)" ::: "memory");
    else if (kt + 1 < NT) asm volatile("s_waitcnt vmcnt(2) lgkmcnt(0)" ::: "memory");
    else asm volatile("s_waitcnt vmcnt(0) lgkmcnt(0)" ::: "memory");
    __builtin_amdgcn_s_barrier();
    asm volatile("" ::: "memory");
    if (kt + 3 < NT) ATT_DMA(kt + 3);
    if (kt < my_nt) {
      const char* img = lds + (kt & 3) * 16384 + lane * 16;
      bf16x8 kf[4], vf[4][2];
#pragma unroll
      for (int s = 0; s < 4; ++s) kf[s] = *(const bf16x8*)(img + (comp * 4 + s) * 1024);
      __builtin_amdgcn_sched_barrier(0);
      f32x16 S;
#pragma unroll
      for (int i = 0; i < 16; ++i) S[i] = 0.f;
#pragma unroll
      for (int s = 0; s < 4; ++s) S = __builtin_amdgcn_mfma_f32_32x32x16_bf16(kf[s], qf[s], S, 0, 0, 0);
      __builtin_amdgcn_sched_barrier(0);
#pragma unroll
      for (int db = 0; db < 4; ++db)
#pragma unroll
        for (int s = 0; s < 2; ++s) vf[db][s] = *(const bf16x8*)(img + (8 + db * 2 + s) * 1024);
      __builtin_amdgcn_sched_barrier(0);
      unsigned pw[8];
      attn0_ptile(S, qposf - (float)(kt * 32 + 4 * hh), slope2, false, l, pw);
#pragma unroll
      for (int s = 0; s < 2; ++s) {
        const bf16x8 pf = mk8(pw[4 * s], pw[4 * s + 1], pw[4 * s + 2], pw[4 * s + 3]);
#pragma unroll
        for (int db = 0; db < 4; ++db) O[db] = __builtin_amdgcn_mfma_f32_32x32x16_bf16(vf[db][s], pf, O[db], 0, 0, 0);
      }
    }
  }
#undef ATT_DMA
  l += __shfl_xor(l, 32);
  float* ldsx = (float*)(lds + 65536 + pair * 16384);
  const size_t trow = (size_t)b * 2048 + qblk * 32 + r;
  uint2 gtp[4][4];
  if (comp == 0) attn0_gate_load(p, trow, h, hh, gtp);
  if (comp == 1) {
    const float c2 = neg_lam / l;
#pragma unroll
    for (int db = 0; db < 4; ++db)
#pragma unroll
      for (int i = 0; i < 16; ++i) ldsx[(db * 16 + i) * 64 + lane] = c2 * O[db][i];
  }
  __syncthreads();
  if (comp == 0) {
    const float c1 = 1.f / l;
#pragma unroll
    for (int db = 0; db < 4; ++db)
#pragma unroll
      for (int i = 0; i < 16; ++i) O[db][i] = c1 * O[db][i] + ldsx[(db * 16 + i) * 64 + lane];
    attn0_finish(p, O, trow, h, hh, true, gtp);
  }
}

DEV void attn0_sample(const Params& p, int b, int h, char* lds, int lane, int w, float neg_lam) {
  const int pair = w >> 1, comp = w & 1;
  const int r = lane & 31, hh = lane >> 5;
  char* ws = p.ws;
  bf16x8 qf[4];
  {
    const u16* qb = (const u16*)(ws + WS_QFS) + (size_t)(b * 16 + 2 * h + comp) * 2048;
#pragma unroll
    for (int s = 0; s < 4; ++s) qf[s] = *(const bf16x8*)(qb + s * 512 + lane * 8);
  }
  const int kt0 = pair * 16, kt1 = kt0 + 16 + (pair == 3 ? 1 : 0);
  const float slope2 = exp2f(-(float)(h + 1)) * LOG2E;
  const float qposf = (float)(2048 + r);
  bf16x8 kf[4], vf[4][2];
  auto load_k = [&](int kt) {
    if (kt < 64) {
      const float* base = p.ck0 + (((size_t)b * 2048 + kt * 32 + r) * 8 + h) * 128 + comp * 64 + 8 * hh;
#pragma unroll
      for (int s = 0; s < 4; ++s) {
        const float4 u0 = *(const float4*)(base + 16 * s);
        const float4 u1 = *(const float4*)(base + 16 * s + 4);
        kf[s] = mk8(pk2(u0.x, u0.y), pk2(u0.z, u0.w), pk2(u1.x, u1.y), pk2(u1.z, u1.w));
      }
    } else {
      const u16* kb = (const u16*)(ws + WS_KFS) + (size_t)(b * 16 + 2 * h + comp) * 2048;
#pragma unroll
      for (int s = 0; s < 4; ++s) kf[s] = *(const bf16x8*)(kb + s * 512 + lane * 8);
    }
  };
  auto load_v = [&](int kt) {
    if (kt < 64) {
      const float* base = p.cv0 + (((size_t)b * 2048 + kt * 32 + 4 * hh) * 8 + h) * 128 + r;
#pragma unroll
      for (int db = 0; db < 4; ++db)
#pragma unroll
        for (int s = 0; s < 2; ++s) {
          float f[8];
#pragma unroll
          for (int j = 0; j < 8; ++j) f[j] = base[(size_t)(16 * s + 8 * (j >> 2) + (j & 3)) * 1024 + db * 32];
          vf[db][s] = mk8(pk2(f[0], f[1]), pk2(f[2], f[3]), pk2(f[4], f[5]), pk2(f[6], f[7]));
        }
    } else {
      const u16* vb = (const u16*)(ws + WS_VFS) + (size_t)(b * 8 + h) * 4096;
#pragma unroll
      for (int db = 0; db < 4; ++db)
#pragma unroll
        for (int s = 0; s < 2; ++s) vf[db][s] = *(const bf16x8*)(vb + (db * 2 + s) * 512 + lane * 8);
    }
  };
  f32x16 O[4];
#pragma unroll
  for (int db = 0; db < 4; ++db)
#pragma unroll
    for (int i = 0; i < 16; ++i) O[db][i] = 0.f;
  float l = 0.f;
  load_k(kt0);
  load_v(kt0);
  for (int kt = kt0; kt < kt1; ++kt) {
    f32x16 S;
#pragma unroll
    for (int i = 0; i < 16; ++i) S[i] = 0.f;
#pragma unroll
    for (int s = 0; s < 4; ++s) S = __builtin_amdgcn_mfma_f32_32x32x16_bf16(kf[s], qf[s], S, 0, 0, 0);
    if (kt + 1 < kt1) load_k(kt + 1);
    unsigned pw[8];
    attn0_ptile(S, qposf - (float)(kt * 32 + 4 * hh), slope2, kt == 64, l, pw);
#pragma unroll
    for (int s = 0; s < 2; ++s) {
      const bf16x8 pf = mk8(pw[4 * s], pw[4 * s + 1], pw[4 * s + 2], pw[4 * s + 3]);
#pragma unroll
      for (int db = 0; db < 4; ++db) O[db] = __builtin_amdgcn_mfma_f32_32x32x16_bf16(vf[db][s], pf, O[db], 0, 0, 0);
    }
    if (kt + 1 < kt1) load_v(kt + 1);
  }
  float* slot = (float*)lds;
  float* lsum = (float*)(lds + 131072);
#pragma unroll
  for (int db = 0; db < 4; ++db)
#pragma unroll
    for (int i = 0; i < 16; ++i) slot[(w * 64 + db * 16 + i) * 64 + lane] = O[db][i];
  lsum[w * 64 + lane] = l;
  __syncthreads();
  if (w == 0) {
    float l1 = 0.f, l2 = 0.f;
#pragma unroll
    for (int q = 0; q < 4; ++q) { l1 += lsum[(2 * q) * 64 + lane]; l2 += lsum[(2 * q + 1) * 64 + lane]; }
    l1 += __shfl_xor(l1, 32);
    l2 += __shfl_xor(l2, 32);
    const float c1 = 1.f / l1, c2 = neg_lam / l2;
#pragma unroll
    for (int db = 0; db < 4; ++db)
#pragma unroll
      for (int i = 0; i < 16; ++i) {
        float o1 = 0.f, o2 = 0.f;
#pragma unroll
        for (int q = 0; q < 4; ++q) {
          o1 += slot[((2 * q) * 64 + db * 16 + i) * 64 + lane];
          o2 += slot[((2 * q + 1) * 64 + db * 16 + i) * 64 + lane];
        }
        O[db][i] = c1 * o1 + c2 * o2;
      }
    uint2 gtp[4][4];
    attn0_gate_load(p, (size_t)(NTOK_P + b * 16 + (r & 15)), h, hh, gtp);
    attn0_finish(p, O, (size_t)(NTOK_P + b * 16 + r), h, hh, r < 16, gtp);
  }
}

template <bool SAMPLE>
DEV void attn1_run(const Params& p, int b, int h, int qblk, int lane) {
  const int r = lane & 31, hh = lane >> 5;
  char* ws = p.ws;
  bf16x8 qf[4];
  {
    const u16* qb = SAMPLE ? (const u16*)(ws + WS_QFS) + (size_t)(b * 16 + h) * 2048
                           : (const u16*)(ws + WS_QF) + ((size_t)(b * 16 + h) * 64 + qblk) * 2048;
#pragma unroll
    for (int s = 0; s < 4; ++s) qf[s] = *(const bf16x8*)(qb + s * 512 + lane * 8);
  }
  const u16* kfb = (const u16*)(ws + WS_KF) + (size_t)(b * 16 + h) * 64 * 2048;
  const u16* vfb = (const u16*)(ws + WS_VF) + (size_t)(b * 16 + h) * 64 * 2048;
  const int ntot = SAMPLE ? 65 : (qblk + 1);
  auto load_k = [&](int it, bf16x8 (&kf)[4]) {
    if (SAMPLE && it > 0) {
      const int kt = 64 - it;
      const float* base = p.ck1 + (((size_t)b * 2048 + kt * 32 + r) * 16 + h) * 64 + 8 * hh;
#pragma unroll
      for (int s = 0; s < 4; ++s) {
        const float4 u0 = *(const float4*)(base + 16 * s);
        const float4 u1 = *(const float4*)(base + 16 * s + 4);
        kf[s] = mk8(pk2(u0.x, u0.y), pk2(u0.z, u0.w), pk2(u1.x, u1.y), pk2(u1.z, u1.w));
      }
    } else if (SAMPLE) {
      const u16* kb = (const u16*)(ws + WS_KFS) + (size_t)(b * 16 + h) * 2048;
#pragma unroll
      for (int s = 0; s < 4; ++s) kf[s] = *(const bf16x8*)(kb + s * 512 + lane * 8);
    } else {
      const u16* kb = kfb + (size_t)(qblk - it) * 2048;
#pragma unroll
      for (int s = 0; s < 4; ++s) kf[s] = *(const bf16x8*)(kb + s * 512 + lane * 8);
    }
  };
  auto load_v = [&](int it, bf16x8 (&vf)[2][2]) {
    if (SAMPLE && it > 0) {
      const int kt = 64 - it;
      const float* base = p.cv1 + (((size_t)b * 2048 + kt * 32 + 4 * hh) * 16 + h) * 64 + r;
#pragma unroll
      for (int db = 0; db < 2; ++db)
#pragma unroll
        for (int s = 0; s < 2; ++s) {
          float f[8];
#pragma unroll
          for (int j = 0; j < 8; ++j) f[j] = base[(size_t)(16 * s + 8 * (j >> 2) + (j & 3)) * 1024 + db * 32];
          vf[db][s] = mk8(pk2(f[0], f[1]), pk2(f[2], f[3]), pk2(f[4], f[5]), pk2(f[6], f[7]));
        }
    } else if (SAMPLE) {
      const u16* vb = (const u16*)(ws + WS_VFS) + (size_t)(b * 16 + h) * 2048;
#pragma unroll
      for (int db = 0; db < 2; ++db)
#pragma unroll
        for (int s = 0; s < 2; ++s) vf[db][s] = *(const bf16x8*)(vb + (db * 2 + s) * 512 + lane * 8);
    } else {
      const u16* vb = vfb + (size_t)(qblk - it) * 2048;
#pragma unroll
      for (int db = 0; db < 2; ++db)
#pragma unroll
        for (int s = 0; s < 2; ++s) vf[db][s] = *(const bf16x8*)(vb + (db * 2 + s) * 512 + lane * 8);
    }
  };

  f32x16 O[2];
#pragma unroll
  for (int db = 0; db < 2; ++db)
#pragma unroll
    for (int i = 0; i < 16; ++i) O[db][i] = 0.f;
  float carry = 0.f;
  const bool qvalid = !SAMPLE || r < 16;

  auto process = [&](int it, bf16x8 (&kf)[4], bf16x8 (&vf)[2][2]) -> bool {
    f32x16 S;
#pragma unroll
    for (int i = 0; i < 16; ++i) S[i] = 0.f;
#pragma unroll
    for (int s = 0; s < 4; ++s) S = __builtin_amdgcn_mfma_f32_32x32x16_bf16(kf[s], qf[s], S, 0, 0, 0);
    if (it + 2 < ntot) load_k(it + 2, kf);
    const int thr = (it == 0) ? (r - 4 * hh) : 1000;
    float x[16], lb[16];
#pragma unroll
    for (int i = 0; i < 16; ++i) {
      const int ci = (i & 3) + 8 * (i >> 2);
      const float z2 = S[i];
      const float e = ex2(z2);
      const float L = lg2(1.f + e);
      const bool valid = ci < thr;
      x[i] = valid ? -L : 0.f;
      lb[i] = z2 - L;
    }
    float T[4], Tp[4];
#pragma unroll
    for (int g = 0; g < 4; ++g) {
      T[g] = (x[4 * g] + x[4 * g + 1]) + (x[4 * g + 2] + x[4 * g + 3]);
      Tp[g] = __shfl_xor(T[g], 32);
    }
    float su[4];
    su[3] = 0.f;
    su[2] = T[3] + Tp[3];
    su[1] = su[2] + (T[2] + Tp[2]);
    su[0] = su[1] + (T[1] + Tp[1]);
    const float total = su[0] + (T[0] + Tp[0]);
    unsigned pw[8];
#pragma unroll
    for (int g = 0; g < 4; ++g) {
      const float gs = carry + su[g] + (hh == 0 ? Tp[g] : 0.f);
      const float a3 = gs;
      const float a2 = a3 + x[4 * g + 3];
      const float a1 = a2 + x[4 * g + 2];
      const float a0 = a1 + x[4 * g + 1];
      const int c0 = 8 * g;
      const float w0 = (c0 + 0 < thr) ? ex2(lb[4 * g + 0] + a0) : 0.f;
      const float w1 = (c0 + 1 < thr) ? ex2(lb[4 * g + 1] + a1) : 0.f;
      const float w2 = (c0 + 2 < thr) ? ex2(lb[4 * g + 2] + a2) : 0.f;
      const float w3 = (c0 + 3 < thr) ? ex2(lb[4 * g + 3] + a3) : 0.f;
      pw[2 * g] = pk2(w0, w1);
      pw[2 * g + 1] = pk2(w2, w3);
    }
    carry += total;
#pragma unroll
    for (int s = 0; s < 2; ++s) {
      const bf16x8 pf = mk8(pw[4 * s], pw[4 * s + 1], pw[4 * s + 2], pw[4 * s + 3]);
#pragma unroll
      for (int db = 0; db < 2; ++db) O[db] = __builtin_amdgcn_mfma_f32_32x32x16_bf16(vf[db][s], pf, O[db], 0, 0, 0);
    }
    if (__all((carry < -64.f) || !qvalid)) return true;
    if (it + 2 < ntot) load_v(it + 2, vf);
    return false;
  };

  bf16x8 kA[4], kB[4], vA[2][2], vB[2][2];
  load_k(0, kA);
  load_v(0, vA);
  if (ntot > 1) { load_k(1, kB); load_v(1, vB); }
  for (int it = 0; it < ntot; it += 2) {
    if (process(it, kA, vA)) break;
    if (it + 1 >= ntot) break;
    if (process(it + 1, kB, vB)) break;
  }
  if (qvalid) {
    const size_t t = SAMPLE ? (size_t)(NTOK_P + b * 16 + r) : ((size_t)b * 2048 + qblk * 32 + r);
    const u16* sgp = (const u16*)(ws + WS_SG) + t * 1024 + h * 64;
    u16* ogp = (u16*)(ws + WS_ACT) + t * 1024 + h * 64;
#pragma unroll
    for (int db = 0; db < 2; ++db)
#pragma unroll
      for (int g = 0; g < 4; ++g) {
        const int d = db * 32 + 8 * g + 4 * hh;
        const uint2 gt = *(const uint2*)(sgp + d);
        uint2 o;
        o.x = pk2(O[db][4 * g + 0] * bflo(gt.x), O[db][4 * g + 1] * bfhi(gt.x));
        o.y = pk2(O[db][4 * g + 2] * bflo(gt.y), O[db][4 * g + 3] * bfhi(gt.y));
        *(uint2*)(ogp + d) = o;
      }
  }
}

#define XB_TMO      128
#define XB_XCNT(j)  (256  + 64 * (j))
#define XB_XSUB(j)  (1280 + 64 * (j))
#define XB_XGEN(j)  (2304 + 64 * (j))
#define XB_TOP      3328
#define XB_TOPGEN   3392
#define XCD_BAR_WORDS 3456
#define XB_SPIN_CAP (1u << 18)
#define XB_LAS __attribute__((address_space(3)))
DEV unsigned xb_ld(unsigned* p)              { return __hip_atomic_load(p, __ATOMIC_RELAXED, __HIP_MEMORY_SCOPE_AGENT); }
DEV unsigned xb_add(unsigned* p, unsigned v) { return __hip_atomic_fetch_add(p, v, __ATOMIC_RELAXED, __HIP_MEMORY_SCOPE_AGENT); }
DEV unsigned xb_xcc_id() { return (unsigned)__builtin_amdgcn_s_getreg((3 << 11) | 20) & 0xFu; }
#define XB_SPIN(cond, bar) do { unsigned _sp = 0; while (cond) { __builtin_amdgcn_s_sleep(1); \
    if ((++_sp & 255u) == 0u) { if (xb_ld(&(bar)[XB_TMO])) break; if (_sp > XB_SPIN_CAP) { atomicAdd(&(bar)[XB_TMO], 1u); break; } } } } while (0)
struct XcdBarrier { unsigned* bar; unsigned x; volatile XB_LAS unsigned* st; };
DEV XcdBarrier xcd_barrier_post(unsigned* bar, volatile XB_LAS unsigned* st) {
  XcdBarrier b; b.bar = bar; b.x = xb_xcc_id(); b.st = st;
  if (threadIdx.x == 0) (void)xb_add(&bar[XB_XCNT(b.x)], 1u);
  return b;
}
DEV void xcd_barrier_complete(unsigned* bar, unsigned x, unsigned& nloc, unsigned& nx) {
  const unsigned G = gridDim.x * gridDim.y * gridDim.z;
  unsigned sum, cnt, mine, sp = 0u;
  for (;;) {
    sum = 0u; cnt = 0u; mine = 0u;
#pragma unroll
    for (unsigned j = 0; j < 16; ++j) { const unsigned c = xb_ld(&bar[XB_XCNT(j)]); sum += c; cnt += (c > 0u) ? 1u : 0u; mine = (j == x) ? c : mine; }
    if (sum == G) break;
    __builtin_amdgcn_s_sleep(1);
    if ((++sp & 255u) == 0u) { if (xb_ld(&bar[XB_TMO])) break; if (sp > XB_SPIN_CAP) { atomicAdd(&bar[XB_TMO], 1u); break; } }
  }
  nloc = mine > 0u ? mine : 1u; nx = cnt > 0u ? cnt : 1u;
}
DEV void xcd_barrier(const XcdBarrier& b) {
  asm volatile("s_waitcnt vmcnt(0)" ::: "memory");
  __syncthreads();
  if (threadIdx.x == 0) {
    unsigned* bar = b.bar;
    __builtin_amdgcn_s_waitcnt(0);
    unsigned nloc = b.st[0], nx = b.st[1];
    if (nloc == 0u) { xcd_barrier_complete(bar, b.x, nloc, nx); b.st[0] = nloc; b.st[1] = nx; }
    const unsigned old = xb_add(&bar[XB_XSUB(b.x)], 1u);
    const unsigned gen = old / nloc;
    if (old + 1u == (gen + 1u) * nloc) {
      __builtin_amdgcn_fence(__ATOMIC_RELEASE, "agent");
      asm volatile("s_waitcnt vmcnt(0)" ::: "memory");
      const unsigned og = xb_add(&bar[XB_TOP], 1u);
      const unsigned tg = og / nx;
      if (og + 1u == (tg + 1u) * nx) xb_add(&bar[XB_TOPGEN], 1u);
      else XB_SPIN(xb_ld(&bar[XB_TOPGEN]) == tg, bar);
      __builtin_amdgcn_fence(__ATOMIC_ACQUIRE, "agent");
      xb_add(&bar[XB_XGEN(b.x)], 1u);
      asm volatile("s_waitcnt vmcnt(0)" ::: "memory");
    } else {
      XB_SPIN(xb_ld(&bar[XB_XGEN(b.x)]) == gen, bar);
      __builtin_amdgcn_fence(__ATOMIC_ACQUIRE, "agent");
      asm volatile("s_waitcnt vmcnt(0)" ::: "memory");
    }
  }
  __syncthreads();
}

DEV int fetch_unit(unsigned* ctr, int lane) {
  unsigned v = 0;
  if (lane == 0) v = atomicAdd(ctr, 1u);
  return (int)__builtin_amdgcn_readfirstlane(v);
}

__global__ void __launch_bounds__(512, 2) fwd_megakernel(Params p) {
  extern __shared__ __attribute__((aligned(16))) char lds[];
  __shared__ unsigned s_misc[4];
#define s_unit (*(int*)&s_misc[0])
  cg::grid_group grid = cg::this_grid();
#define PHASE_IDS() int tid = threadIdx.x; asm volatile("" : "+v"(tid)); const int lane = tid & 63, w = tid >> 6; const int gw = bid * 8 + w; (void)lane; (void)gw;
  const int nblk = gridDim.x, bid = blockIdx.x;
  const int ngw = nblk * 8;
  char* ws = p.ws;
  unsigned* cnt = (unsigned*)(ws + WS_CNT);
  PG8_LAS unsigned char* ldsg = (PG8_LAS unsigned char*)lds;
  pg8::StaticOrder S;

  if (p.ws == nullptr) grid.sync();
  const XcdBarrier xbar = xcd_barrier_post((unsigned*)(ws + WS_BAR), (volatile XB_LAS unsigned*)&s_misc[1]);

  {
  PHASE_IDS();
  if (tid < 4) s_misc[tid] = 0u;
  {
    uint4* z = (uint4*)(ws + WS_QFS);
    for (int i = bid * 512 + tid; i < 98304; i += nblk * 512) z[i] = make_uint4(0, 0, 0, 0);
  }
  for (int id = bid; id < 2560; id += nblk) {
    if (id < 1024)      transpose_tile(p.w_in0, 4096, (u16*)(ws + WS_WT_IN0), (id >> 6) * 64, (id & 63) * 64, (float*)lds);
    else if (id < 1280) transpose_tile(p.w_out0, 1024, (u16*)(ws + WS_WT_OUT0), ((id - 1024) >> 4) * 64, ((id - 1024) & 15) * 64, (float*)lds);
    else if (id < 2304) transpose_tile(p.w_in1, 4096, (u16*)(ws + WS_WT_IN1), ((id - 1280) >> 6) * 64, ((id - 1280) & 63) * 64, (float*)lds);
    else                transpose_tile(p.w_out1, 1024, (u16*)(ws + WS_WT_OUT1), ((id - 2304) >> 4) * 64, ((id - 2304) & 15) * 64, (float*)lds);
  }
  norm_rows([&](int row) { return row < NTOK_P ? p.x_prompt + (size_t)row * 1024 : p.x_sample + (size_t)(row - NTOK_P) * 1024; },
            p.norm_g0, (u16*)(ws + WS_ACT), gw, ngw, lane);
  }
  xcd_barrier(xbar);

  {
    S.init(NTOK_P, 4096, nblk, bid);
    pg8::Gemm g{(const u16*)(ws + WS_ACT), (const u16*)(ws + WS_WT_IN0), NTOK_P, 4096, 1024};
    EpiIn<0> E{p, lds + pg8::STAGE_BYTES};
    pg8::gemm_phase(ldsg, g, S, E);
    for (int st = bid; st < 32; st += nblk) {
      f32x4 acc[4][2];
      gemm_tile((const u16*)(ws + WS_WT_IN0), (const u16*)(ws + WS_ACT), st * 128, NTOK_P, lds, acc);
      inproj_epilogue<0>(p, acc, st * 128, NTOK_P);
    }
  }
  xcd_barrier(xbar);

  {
    PHASE_IDS();
    float a1 = p.lq1[lane] * p.lk1[lane], a2 = p.lq2[lane] * p.lk2[lane];
    a1 = wave_sum(a1);
    a2 = wave_sum(a2);
    const float lam = __expf(a1) - __expf(a2) + 0.2f;
    const int wu = __builtin_amdgcn_readfirstlane(w);
    float gq = fabsf(p.q_norm[lane]), gk = fabsf(p.k_norm[lane]);
#pragma unroll
    for (int o = 32; o; o >>= 1) { gq = fmaxf(gq, __shfl_xor(gq, o)); gk = fmaxf(gk, __shfl_xor(gk, o)); }
    const float smax2 = 8.f * gq * gk * LOG2E * 1.02f;
    for (;;) {
      __syncthreads();
      if (tid == 0) s_unit = (int)atomicAdd(cnt + 0, 1u);
      __syncthreads();
      const int u = s_unit;
      if (u >= 64 + 2048) break;
      if (u < 64) attn0_sample(p, u >> 3, u & 7, lds, lane, wu, -lam);
      else {
        const int v = u - 64;
        const int hh_ = v & 7, cp_ = 15 - (v >> 7);
        const float dmin = (2.f * smax2 + 75.f) / (exp2f(-(float)(hh_ + 1)) * LOG2E);
        int kt0 = 0;
        if (dmin < 4096.f) {
          const int num = 128 * cp_ - 31 - (int)ceilf(dmin);
          if (num >= 0) kt0 = num / 32 + 1;
        }
        kt0 = __builtin_amdgcn_readfirstlane(kt0);
        attn0_prompt(p, (v & 127) >> 3, hh_, cp_, kt0, lds, lane, wu, -lam);
      }
    }
  }
  xcd_barrier(xbar);

  {
    S.init(NTOK_P, 1024, nblk, bid);
    pg8::Gemm g{(const u16*)(ws + WS_ACT), (const u16*)(ws + WS_WT_OUT0), NTOK_P, 1024, 1024};
    EpiOut<0> E{p};
    pg8::gemm_phase(ldsg, g, S, E);
    for (int st = bid; st < 8; st += nblk) {
      f32x4 acc[4][2];
      gemm_tile((const u16*)(ws + WS_WT_OUT0), (const u16*)(ws + WS_ACT), st * 128, NTOK_P, lds, acc);
      outproj_epilogue<0>(p, acc, st * 128, NTOK_P);
    }
  }
  xcd_barrier(xbar);

  {
    PHASE_IDS();
    norm_rows([&](int row) { return (const float*)(p.out + (size_t)row * 1024); }, p.norm_g1, (u16*)(ws + WS_ACT), gw, ngw, lane);
  }
  xcd_barrier(xbar);

  {
    S.init(NTOK_P, 4096, nblk, bid);
    pg8::Gemm g{(const u16*)(ws + WS_ACT), (const u16*)(ws + WS_WT_IN1), NTOK_P, 4096, 1024};
    EpiIn<1> E{p, lds + pg8::STAGE_BYTES};
    pg8::gemm_phase(ldsg, g, S, E);
    for (int st = bid; st < 32; st += nblk) {
      f32x4 acc[4][2];
      gemm_tile((const u16*)(ws + WS_WT_IN1), (const u16*)(ws + WS_ACT), st * 128, NTOK_P, lds, acc);
      inproj_epilogue<1>(p, acc, st * 128, NTOK_P);
    }
  }
  xcd_barrier(xbar);

  {
  PHASE_IDS();
  for (int u = gw; u < 128 + 16384; u += ngw) {
    if (u < 128) attn1_run<true>(p, u >> 4, u & 15, 0, lane);
    else {
      const int v = u - 128;
      attn1_run<false>(p, (v & 255) >> 4, v & 15, 63 - (v >> 8), lane);
    }
  }
  }
  xcd_barrier(xbar);

  {
    S.init(NTOK_P, 1024, nblk, bid);
    pg8::Gemm g{(const u16*)(ws + WS_ACT), (const u16*)(ws + WS_WT_OUT1), NTOK_P, 1024, 1024};
    EpiOut<1> E{p};
    pg8::gemm_phase(ldsg, g, S, E);
    for (int st = bid; st < 8; st += nblk) {
      f32x4 acc[4][2];
      gemm_tile((const u16*)(ws + WS_WT_OUT1), (const u16*)(ws + WS_ACT), st * 128, NTOK_P, lds, acc);
      outproj_epilogue<1>(p, acc, st * 128, NTOK_P);
    }
  }
}

extern "C" void kernel_launch(void* const* d_in, const int* in_sizes, int n_in, void* d_out, int out_size, void* d_ws,
                              size_t ws_size, hipStream_t stream) {
  Params p{};
  p.x_prompt = (const float*)d_in[0]; p.x_sample = (const float*)d_in[1];
  p.ck0 = (const float*)d_in[2]; p.cv0 = (const float*)d_in[3]; p.ck1 = (const float*)d_in[4]; p.cv1 = (const float*)d_in[5];
  p.norm_g0 = (const float*)d_in[6]; p.w_in0 = (const float*)d_in[7]; p.q_norm = (const float*)d_in[8]; p.k_norm = (const float*)d_in[9];
  p.lq1 = (const float*)d_in[10]; p.lk1 = (const float*)d_in[11]; p.lq2 = (const float*)d_in[12]; p.lk2 = (const float*)d_in[13];
  p.subln_g = (const float*)d_in[14]; p.w_out0 = (const float*)d_in[15]; p.norm_g1 = (const float*)d_in[16];
  p.w_in1 = (const float*)d_in[17]; p.w_out1 = (const float*)d_in[18];
  p.out = (float*)d_out;
  p.ws = (char*)d_ws;
  static int grid_blocks = 0;
  if (!grid_blocks) {
    int dev = 0, cus = 0, per_cu = 0;
    hipGetDevice(&dev);
    hipFuncSetAttribute((const void*)fwd_megakernel, hipFuncAttributeMaxDynamicSharedMemorySize, LDS_BYTES);
    hipDeviceGetAttribute(&cus, hipDeviceAttributeMultiprocessorCount, dev);
    hipOccupancyMaxActiveBlocksPerMultiprocessor(&per_cu, fwd_megakernel, 512, LDS_BYTES);
    if (per_cu < 1) per_cu = 1;
    if (per_cu > 1) per_cu = 1;
    grid_blocks = cus * per_cu;
  }
  hipMemsetAsync((char*)d_ws + WS_CNT, 0, 256 + XCD_BAR_WORDS * 4, stream);
  void* args[] = {&p};
  hipError_t e = hipLaunchCooperativeKernel((void*)fwd_megakernel, dim3(grid_blocks), dim3(512), args, LDS_BYTES, stream);
  if (e != hipSuccess) fprintf(stderr, "cooperative launch failed: %s (grid %d)\n", hipGetErrorString(e), grid_blocks);
}
```

```cpp
#include <hip/hip_runtime.h>
#include <hip/hip_cooperative_groups.h>
#include <cstdio>
namespace cg = cooperative_groups;

typedef __attribute__((ext_vector_type(8))) short bf16x8;
typedef __attribute__((ext_vector_type(4))) float f32x4;
typedef __attribute__((ext_vector_type(16))) float f32x16;
typedef __attribute__((ext_vector_type(2))) __bf16 bf2_t;
typedef unsigned short u16;

#define DEV __device__ __forceinline__

constexpr int NTOK_P = 32768;
constexpr int NTOK = 32896;
constexpr size_t NP = 33554432, NS = 131072;
constexpr size_t OFF_K0P = NP + NS, OFF_V0P = 2 * NP + NS, OFF_K0S = 3 * NP + NS, OFF_V0S = 3 * NP + 2 * NS;
constexpr size_t OFF_K1P = 3 * NP + 3 * NS, OFF_V1P = 4 * NP + 3 * NS, OFF_K1S = 5 * NP + 3 * NS, OFF_V1S = 5 * NP + 4 * NS;

constexpr size_t WS_WT_IN0 = 0;
constexpr size_t WS_WT_OUT0 = 8388608;
constexpr size_t WS_WT_IN1 = 10485760;
constexpr size_t WS_WT_OUT1 = 18874368;
constexpr size_t WS_ACT = 20971520;
constexpr size_t WS_SG = WS_ACT + 67371008;
constexpr size_t WS_QF = WS_SG + 67371008;
constexpr size_t WS_KF = WS_QF + 67108864;
constexpr size_t WS_VF = WS_KF + 67108864;
constexpr size_t WS_QFS = WS_VF + 67108864;
constexpr size_t WS_KFS = WS_QFS + 524288;
constexpr size_t WS_VFS = WS_KFS + 524288;
constexpr size_t WS_CNT = WS_VFS + 524288;
constexpr size_t WS_BAR = WS_CNT + 256;
constexpr int LDS_BYTES = 131072 + 18432;
constexpr float LOG2E = 1.4426950408889634f;

struct Params {
  const float* x_prompt; const float* x_sample;
  const float* ck0; const float* cv0; const float* ck1; const float* cv1;
  const float* norm_g0; const float* w_in0; const float* q_norm; const float* k_norm;
  const float* lq1; const float* lk1; const float* lq2; const float* lk2;
  const float* subln_g; const float* w_out0; const float* norm_g1; const float* w_in1; const float* w_out1;
  float* out;
  char* ws;
};

DEV unsigned pk2(float a, float b) { bf2_t v; v[0] = (__bf16)a; v[1] = (__bf16)b; return __builtin_bit_cast(unsigned, v); }
DEV u16 f2bf(float a) { __bf16 v = (__bf16)a; return __builtin_bit_cast(u16, v); }
DEV float bflo(unsigned v) { return __uint_as_float(v << 16); }
DEV float bfhi(unsigned v) { return __uint_as_float(v & 0xffff0000u); }
DEV bf16x8 mk8(unsigned a, unsigned b, unsigned c, unsigned d) { uint4 q = make_uint4(a, b, c, d); return __builtin_bit_cast(bf16x8, q); }
DEV float wave_sum(float v) {
#pragma unroll
  for (int o = 32; o; o >>= 1) v += __shfl_xor(v, o);
  return v;
}
DEV int opaque_tid() { int t = threadIdx.x; asm volatile("" : "+v"(t)); return t; }
DEV float ex2(float x) { return __builtin_amdgcn_exp2f(x); }
DEV float lg2(float x) { return __builtin_amdgcn_logf(x); }

typedef __attribute__((ext_vector_type(4))) unsigned u32x4_t;
DEV void nt_store_u4(void* ptr, uint4 v) { u32x4_t q = {v.x, v.y, v.z, v.w}; __builtin_nontemporal_store(q, (u32x4_t*)ptr); }
DEV void nt_store_f4(void* ptr, f32x4 v) { __builtin_nontemporal_store(v, (f32x4*)ptr); }

namespace pg8 {
#define PG8_LAS __attribute__((address_space(3)))
constexpr int BM = 256, BK = 64, HALF = 128, HTB = HALF * BK * 2, STAGE_BYTES = 8 * HTB, NXCD = 8, WGM = 8;
__device__ __forceinline__ int lds_byte(int r, int c) { const int st = (r >> 4) * 2 + (c >> 5), rr = r & 15, cc = c & 31, ob = rr * 64 + cc * 2; return st * 1024 + (ob ^ (((ob >> 9) & 1) << 5)); }
__device__ __forceinline__ void stage_rc(int b, int& R, int& C) { const int st = b / 1024, sb = b % 1024, swz = sb ^ (((sb >> 9) & 1) << 5); R = (st >> 1) * 16 + swz / 64; C = (st & 1) * 32 + (swz % 64) / 2; }
struct Unit { int pm, pn; };
struct Gemm { const u16* A; const u16* Bt; int M, N, K; };
struct StaticOrder {
  int nM, nN, nwg, G, c;
  __device__ void init(int M, int N, int G_, int c_) { nM = M / BM; nN = N / BM; nwg = nM * nN; G = G_; c = c_; }
  __device__ bool next(int i, Unit& u) const {
    const long L = (long)i * G + c; if (L >= nwg) return false;
    int wgid = (int)L; { const int q = nwg / NXCD, r = nwg % NXCD, xcd = wgid % NXCD, off = wgid / NXCD; wgid = (xcd < r ? xcd * (q + 1) : r * (q + 1) + (xcd - r) * q) + off; }
    const int nig = WGM * nN, gid = wgid / nig, fm = gid * WGM, gsz = (nM - fm) < WGM ? (nM - fm) : WGM;
    u.pm = fm + ((wgid % nig) % gsz); u.pn = (wgid % nig) / gsz; return true;
  }
};
template <class Epi>
__device__ __forceinline__ void gemm_phase(PG8_LAS unsigned char* lds, const Gemm g, const StaticOrder& S, const Epi& E) {
  const int tid = opaque_tid(), wid = __builtin_amdgcn_readfirstlane(tid >> 6), lane = tid & 63, wr = wid >> 2, wc = wid & 3, fr = lane & 15, fq = lane >> 4;
  const int K = g.K, nt = K / BK;
  unsigned voffA[2], voffB[2];
#pragma unroll
  for (int i = 0; i < 2; ++i) { int R, C; stage_rc(tid * 16 + i * 8192, R, C); const int Rb = ((R >> 5) << 6) + (R & 31);
    voffA[i] = (unsigned)(R * K + C) * 2u; voffB[i] = (unsigned)(Rb * K + C) * 2u; }
  const size_t kstep = (size_t)(BK * 2);
  const size_t hstep = (size_t)HALF * K * 2;
  const size_t hstepB = (size_t)32 * K * 2;
  const size_t tstep = 2 * hstep;
  const unsigned ldsw = (unsigned)wid * 1024u;
  const int aoff = lds_byte(wr * 64 + fr, fq * 8), boff = lds_byte(wc * 32 + fr, fq * 8);
#define PG8_SA(b, h) (((b) * 2 + (h)) * HTB)
#define PG8_SB(b, h) ((4 + (b) * 2 + (h)) * HTB)
#define PG8_STAGE(bufoff, gbase, voff) do { _Pragma("unroll") for (int _i = 0; _i < 2; ++_i) \
    __builtin_amdgcn_global_load_lds((const __attribute__((address_space(1))) unsigned*)((const char*)(gbase) + (voff)[_i]), (PG8_LAS unsigned*)(lds + (bufoff) + ldsw + _i * 8192), 16, 0, 0); } while (0)
#define PG8_LDA(dst, b, h) do { _Pragma("unroll") for (int m = 0; m < 4; ++m) _Pragma("unroll") for (int k = 0; k < 2; ++k) dst[m][k] = *(const PG8_LAS bf16x8*)(lds + PG8_SA(b, h) + aoff + m * 2048 + k * 1024); } while (0)
#define PG8_LDB(dst, b, h) do { _Pragma("unroll") for (int n = 0; n < 2; ++n) _Pragma("unroll") for (int k = 0; k < 2; ++k) dst[n][k] = *(const PG8_LAS bf16x8*)(lds + PG8_SB(b, h) + boff + n * 2048 + k * 1024); } while (0)
#define PG8_MMA(ai, bj, At, Bt) do { __builtin_amdgcn_s_setprio(1); _Pragma("unroll") for (int m = 0; m < 4; ++m) _Pragma("unroll") for (int n = 0; n < 2; ++n) _Pragma("unroll") for (int k = 0; k < 2; ++k) \
    acc[ai][bj][m][n] = __builtin_amdgcn_mfma_f32_16x16x32_bf16(Bt[n][k], At[m][k], acc[ai][bj][m][n], 0, 0, 0); __builtin_amdgcn_s_setprio(0); } while (0)
#define PG8_WAIT_V(n) asm volatile("s_waitcnt vmcnt(" #n ")" ::: "memory")
#define PG8_WAIT_L(n) asm volatile("s_waitcnt lgkmcnt(" #n ")" ::: "memory")
#define PG8_BAR __builtin_amdgcn_s_barrier()
#define PG8_SCHED __builtin_amdgcn_sched_barrier(0)
  Unit cur, nxt; int ui = 0;
  if (!S.next(0, cur)) return;
  f32x4 acc[2][2][4][2];
#pragma unroll
  for (int a = 0; a < 2; ++a)
#pragma unroll
    for (int b = 0; b < 2; ++b)
#pragma unroll
      for (int m = 0; m < 4; ++m)
#pragma unroll
        for (int n = 0; n < 2; ++n) acc[a][b][m][n] = (f32x4){0.f, 0.f, 0.f, 0.f};
  bf16x8 At[4][2], B0[2][2], B1[2][2];
  const char* cA = (const char*)g.A + (size_t)cur.pm * tstep; const char* cB = (const char*)g.Bt + (size_t)cur.pn * tstep;
  PG8_STAGE(PG8_SB(0, 0), cB, voffB); PG8_STAGE(PG8_SA(0, 0), cA, voffA); PG8_STAGE(PG8_SB(0, 1), cB + hstepB, voffB); PG8_STAGE(PG8_SA(0, 1), cA + hstep, voffA);
  if (wr == 1) PG8_BAR;
  PG8_WAIT_V(4); PG8_BAR;
  PG8_STAGE(PG8_SB(1, 0), cB + kstep, voffB); PG8_STAGE(PG8_SA(1, 0), cA + kstep, voffA); PG8_STAGE(PG8_SB(1, 1), cB + hstepB + kstep, voffB);
  PG8_WAIT_V(6); PG8_BAR;
  for (;;) {
    const bool has_next = S.next(ui + 1, nxt);
    const char* nA = has_next ? (const char*)g.A + (size_t)nxt.pm * tstep : cA; const char* nB = has_next ? (const char*)g.Bt + (size_t)nxt.pn * tstep : cB;
    for (int t = 0; t < nt; t += 2) {
      const bool last = (t == nt - 2);
      const char* a1 = cA + (size_t)(t + 1) * kstep;
      const char* a2 = last ? nA : cA + (size_t)(t + 2) * kstep; const char* b2 = last ? nB : cB + (size_t)(t + 2) * kstep;
      const char* a3 = a2 + kstep; const char* b3 = b2 + kstep;
      PG8_LDB(B0, 0, 0); PG8_SCHED; PG8_LDA(At, 0, 0); PG8_STAGE(PG8_SA(1, 1), a1 + hstep, voffA);
      PG8_WAIT_L(8); PG8_BAR; PG8_WAIT_L(0); PG8_MMA(0, 0, At, B0); PG8_BAR; PG8_SCHED;
      PG8_LDB(B1, 0, 1); PG8_STAGE(PG8_SB(0, 0), b2, voffB);
      PG8_BAR; PG8_WAIT_L(0); PG8_MMA(0, 1, At, B1); PG8_BAR;
      PG8_LDA(At, 0, 1); PG8_STAGE(PG8_SA(0, 0), a2, voffA);
      PG8_BAR; PG8_WAIT_L(0); PG8_MMA(1, 0, At, B0); PG8_BAR; PG8_SCHED;
      PG8_STAGE(PG8_SB(0, 1), b2 + hstepB, voffB);
      PG8_WAIT_V(6); PG8_BAR; PG8_MMA(1, 1, At, B1); PG8_BAR;
      PG8_LDB(B0, 1, 0); PG8_SCHED; PG8_LDA(At, 1, 0); PG8_STAGE(PG8_SA(0, 1), a2 + hstep, voffA);
      PG8_WAIT_L(8); PG8_BAR; PG8_WAIT_L(0); PG8_MMA(0, 0, At, B0); PG8_BAR; PG8_SCHED;
      PG8_LDB(B1, 1, 1); PG8_STAGE(PG8_SB(1, 0), b3, voffB);
      PG8_BAR; PG8_WAIT_L(0); PG8_MMA(0, 1, At, B1); PG8_BAR;
      PG8_LDA(At, 1, 1); PG8_STAGE(PG8_SA(1, 0), a3, voffA);
      PG8_BAR; PG8_WAIT_L(0); PG8_MMA(1, 0, At, B0); PG8_BAR; PG8_SCHED;
      PG8_STAGE(PG8_SB(1, 1), b3 + hstepB, voffB);
      PG8_WAIT_V(6); PG8_BAR; PG8_MMA(1, 1, At, B1); PG8_BAR;
    }
    E(acc, cur, wr, wc, fr, fq);
    if (!has_next) break;
#pragma unroll
    for (int a = 0; a < 2; ++a)
#pragma unroll
      for (int b = 0; b < 2; ++b)
#pragma unroll
        for (int m = 0; m < 4; ++m)
#pragma unroll
          for (int n = 0; n < 2; ++n) acc[a][b][m][n] = (f32x4){0.f, 0.f, 0.f, 0.f};
    cur = nxt; cA = nA; cB = nB; ++ui;
  }
  PG8_WAIT_V(0);
  if (wr == 0) PG8_BAR;
  PG8_BAR;
#undef PG8_SA
#undef PG8_SB
#undef PG8_STAGE
#undef PG8_LDA
#undef PG8_LDB
#undef PG8_MMA
#undef PG8_WAIT_V
#undef PG8_WAIT_L
#undef PG8_BAR
#undef PG8_SCHED
}
}

template <int LAYER>
struct EpiIn {
  Params p; char* xl;
  DEV void operator()(const f32x4 (&acc)[2][2][4][2], const pg8::Unit& u, int wr, int wc, int fr, int fq) const {
    const int lane = fq * 16 + fr;
    const int nb = u.pn * 256 + wc * 64;
    const int region = nb >> 10, f0 = nb & 1023, hc = f0 >> 6;
    char* ws = p.ws;
    u16* vl = (u16*)(xl + (wr * 4 + wc) * 2304);
#pragma unroll
    for (int ai = 0; ai < 2; ++ai) {
      const int tb = u.pm * 256 + ai * 128 + wr * 64;
      if (region <= 1) {
        const float* gn = (region == 0) ? p.q_norm : p.k_norm;
#pragma unroll
        for (int m = 0; m < 4; ++m) {
          const int t = tb + m * 16 + fr;
          const int b = t >> 11, s = t & 2047;
          float rinv = 1.f;
          if (LAYER == 0) {
            float ss = 0.f;
#pragma unroll
            for (int bj = 0; bj < 2; ++bj)
#pragma unroll
              for (int n = 0; n < 2; ++n)
#pragma unroll
                for (int j = 0; j < 4; ++j) ss += acc[ai][bj][m][n][j] * acc[ai][bj][m][n][j];
            ss += __shfl_xor(ss, 16);
            ss += __shfl_xor(ss, 32);
            rinv = rsqrtf(ss * (1.f / 64.f) + 1e-6f);
          }
          u16* fb = (u16*)(ws + (region == 0 ? WS_QF : WS_KF)) + ((size_t)(b * 16 + hc) * 64 + (s >> 5)) * 2048 + ((fq >> 1) * 32 + (s & 31)) * 8 + (fq & 1) * 4;
          float* ko = p.out + (LAYER == 0 ? OFF_K0P : OFF_K1P) + (size_t)t * 1024 + f0 + 4 * fq;
#pragma unroll
          for (int bj = 0; bj < 2; ++bj)
#pragma unroll
            for (int n = 0; n < 2; ++n) {
              f32x4 v = acc[ai][bj][m][n];
              if (LAYER == 0) {
                const f32x4 g4 = *(const f32x4*)(gn + 32 * bj + 16 * n + 4 * fq);
                v = v * g4 * rinv;
              }
              if (region == 1) nt_store_f4(ko + 32 * bj + 16 * n, v);
              if (region == 0) v = v * (0.125f * LOG2E);
              uint2 pk;
              pk.x = pk2(v[0], v[1]);
              pk.y = pk2(v[2], v[3]);
              *(uint2*)(fb + (2 * bj + n) * 512) = pk;
            }
        }
      } else if (region == 2) {
#pragma unroll
        for (int m = 0; m < 4; ++m) {
          float* vo = p.out + (LAYER == 0 ? OFF_V0P : OFF_V1P) + (size_t)(tb + m * 16 + fr) * 1024 + f0 + 4 * fq;
#pragma unroll
          for (int bj = 0; bj < 2; ++bj)
#pragma unroll
            for (int n = 0; n < 2; ++n) nt_store_f4(vo + 32 * bj + 16 * n, acc[ai][bj][m][n]);
        }
        const int r = lane & 31, hh = lane >> 5;
#pragma unroll
        for (int mp = 0; mp < 2; ++mp) {
          const int tk = tb + mp * 32;
          const int b = tk >> 11, tile = (tk & 2047) >> 5;
#pragma unroll
          for (int bj = 0; bj < 2; ++bj) {
#pragma unroll
            for (int mm = 0; mm < 2; ++mm)
#pragma unroll
              for (int n = 0; n < 2; ++n)
#pragma unroll
                for (int j = 0; j < 4; ++j) vl[(16 * n + 4 * fq + j) * 36 + mm * 16 + fr] = f2bf(acc[ai][bj][2 * mp + mm][n][j]);
            u16* vb;
            if (LAYER == 0) vb = (u16*)(ws + WS_VF) + ((size_t)(b * 8 + (f0 >> 7)) * 64 + tile) * 4096 + ((((f0 & 127) >> 5) + bj) * 2) * 512 + lane * 8;
            else            vb = (u16*)(ws + WS_VF) + ((size_t)(b * 16 + hc) * 64 + tile) * 2048 + (bj * 2) * 512 + lane * 8;
#pragma unroll
            for (int sv = 0; sv < 2; ++sv) {
              const uint2 lo = *(const uint2*)(vl + r * 36 + 16 * sv + 4 * hh);
              const uint2 hi = *(const uint2*)(vl + r * 36 + 16 * sv + 8 + 4 * hh);
              *(uint4*)(vb + sv * 512) = make_uint4(lo.x, lo.y, hi.x, hi.y);
            }
          }
        }
      } else {
#pragma unroll
        for (int m = 0; m < 4; ++m) {
          u16* sg = (u16*)(ws + WS_SG) + (size_t)(tb + m * 16 + fr) * 1024 + f0 + 4 * fq;
#pragma unroll
          for (int bj = 0; bj < 2; ++bj)
#pragma unroll
            for (int n = 0; n < 2; ++n) {
              float v[4];
#pragma unroll
              for (int j = 0; j < 4; ++j) { const float x = acc[ai][bj][m][n][j]; v[j] = x * __builtin_amdgcn_rcpf(1.f + __expf(-x)); }
              uint2 pk;
              pk.x = pk2(v[0], v[1]);
              pk.y = pk2(v[2], v[3]);
              *(uint2*)(sg + 32 * bj + 16 * n) = pk;
            }
        }
      }
    }
  }
};

template <int LAYER>
struct EpiOut {
  Params p;
  DEV void operator()(const f32x4 (&acc)[2][2][4][2], const pg8::Unit& u, int wr, int wc, int fr, int fq) const {
    const int col = u.pn * 256 + wc * 64 + 4 * fq;
    const size_t t0 = (size_t)(u.pm * 256 + wr * 64 + fr);
    f32x4 xr[3][4];
    auto rowp = [&](int g) { return (size_t)(t0 + (g >> 2) * 128 + (g & 3) * 16) * 1024 + col; };
    auto ldg = [&](int g, f32x4 (&x)[4]) {
      const float* xi = ((LAYER == 0) ? p.x_prompt : (const float*)p.out) + rowp(g);
#pragma unroll
      for (int q = 0; q < 4; ++q) x[q] = *(const f32x4*)(xi + 32 * (q >> 1) + 16 * (q & 1));
    };
    ldg(0, xr[0]);
    ldg(1, xr[1]);
#pragma unroll
    for (int g = 0; g < 8; ++g) {
      if (g + 2 < 8) ldg(g + 2, xr[(g + 2) % 3]);
      float* yo = p.out + rowp(g);
#pragma unroll
      for (int q = 0; q < 4; ++q) *(f32x4*)(yo + 32 * (q >> 1) + 16 * (q & 1)) = xr[g % 3][q] + acc[g >> 2][q >> 1][g & 3][q & 1];
    }
  }
};

DEV void gemm_tile(const u16* __restrict__ Wt, const u16* __restrict__ X, int n0, int m0, char* lds, f32x4 (&acc)[4][2]) {
  const int tid = opaque_tid(), lane = tid & 63, w = tid >> 6;
  const int wa = w & 1, wb = w >> 1;
  const int lr = lane & 15, lq = lane >> 4;
  const int srow = tid >> 3, skc = (tid & 7) ^ (srow & 7);
  const u16* ga = Wt + (size_t)(n0 + srow) * 1024 + skc * 8;
  const u16* gb = X + (size_t)(m0 + srow) * 1024 + skc * 8;
  typedef __attribute__((address_space(3))) unsigned lds_u32;
  typedef const __attribute__((address_space(1))) unsigned glb_u32;
#define GLDS(gp, lp) __builtin_amdgcn_global_load_lds((glb_u32*)(gp), (lds_u32*)(lp), 16, 0, 0)
#define GT_STAGE(kt) do { char* d_ = sdst + ((kt) & 3) * 32768; const int ko_ = (kt) * 64; \
    GLDS(ga + ko_, d_); GLDS(ga + (size_t)64 * 1024 + ko_, d_ + 8192); \
    GLDS(gb + ko_, d_ + 16384); GLDS(gb + (size_t)64 * 1024 + ko_, d_ + 16384 + 8192); } while (0)
#pragma unroll
  for (int mt = 0; mt < 4; ++mt)
#pragma unroll
    for (int nt = 0; nt < 2; ++nt) acc[mt][nt] = f32x4{0.f, 0.f, 0.f, 0.f};
  char* sdst = lds + tid * 16;
  __syncthreads();
  GT_STAGE(0); GT_STAGE(1); GT_STAGE(2);
  const int aoff = (wa * 64 + lr) * 128;
  const int boff = 16384 + (wb * 32 + lr) * 128;
  const int sw = lr & 7;
  for (int kt = 0; kt < 16; ++kt) {
    if (kt + 2 < 16) asm volatile("s_waitcnt vmcnt(8) lgkmcnt(0)" ::: "memory");
    else if (kt + 1 < 16) asm volatile("s_waitcnt vmcnt(4) lgkmcnt(0)" ::: "memory");
    else asm volatile("s_waitcnt vmcnt(0) lgkmcnt(0)" ::: "memory");
    __builtin_amdgcn_s_barrier();
    asm volatile("" ::: "memory");
    if (kt + 3 < 16) GT_STAGE(kt + 3);
    const char* cur = lds + (kt & 3) * 32768;
#pragma unroll
    for (int kk = 0; kk < 2; ++kk) {
      bf16x8 a[4], b[2];
      const int co = ((kk * 4 + lq) ^ sw) << 4;
#pragma unroll
      for (int mt = 0; mt < 4; ++mt) a[mt] = *(const bf16x8*)(cur + aoff + mt * 2048 + co);
#pragma unroll
      for (int nt = 0; nt < 2; ++nt) b[nt] = *(const bf16x8*)(cur + boff + nt * 2048 + co);
#pragma unroll
      for (int mt = 0; mt < 4; ++mt)
#pragma unroll
        for (int nt = 0; nt < 2; ++nt)
          acc[mt][nt] = __builtin_amdgcn_mfma_f32_16x16x32_bf16(a[mt], b[nt], acc[mt][nt], 0, 0, 0);
    }
  }
  __syncthreads();
#undef GLDS
#undef GT_STAGE
}

template <int LAYER>
DEV void inproj_epilogue(const Params& p, f32x4 (&acc)[4][2], int n0, int m0) {
  const int tid = opaque_tid(), lane = tid & 63, w = tid >> 6;
  const int wa = w & 1, wb = w >> 1;
  const int lr = lane & 15, lq = lane >> 4;
  const int region = n0 >> 10;
  const int f0 = (n0 & 1023) + wa * 64;
  const int hc = f0 >> 6;
  char* ws = p.ws;
#pragma unroll
  for (int nt = 0; nt < 2; ++nt) {
    const int t = m0 + wb * 32 + nt * 16 + lr;
    const bool samp = t >= NTOK_P;
    const int ts = t - NTOK_P;
    const int b = samp ? (ts >> 4) : (t >> 11);
    const int s = samp ? (ts & 15) : (t & 2047);
    if (region <= 1) {
      float rinv = 1.f;
      if (LAYER == 0) {
        float ss = 0.f;
#pragma unroll
        for (int mt = 0; mt < 4; ++mt)
#pragma unroll
          for (int j = 0; j < 4; ++j) ss += acc[mt][nt][j] * acc[mt][nt][j];
        ss += __shfl_xor(ss, 16);
        ss += __shfl_xor(ss, 32);
        rinv = rsqrtf(ss * (1.f / 64.f) + 1e-6f);
      }
      const float qscale = (region == 0) ? (0.125f * LOG2E) : 1.f;
      const float* gn = (region == 0) ? p.q_norm : p.k_norm;
      u16* fb;
      if (region == 0)
        fb = samp ? (u16*)(ws + WS_QFS) + (size_t)(b * 16 + hc) * 2048
                  : (u16*)(ws + WS_QF) + ((size_t)(b * 16 + hc) * 64 + (s >> 5)) * 2048;
      else
        fb = samp ? (u16*)(ws + WS_KFS) + (size_t)(b * 16 + hc) * 2048
                  : (u16*)(ws + WS_KF) + ((size_t)(b * 16 + hc) * 64 + (s >> 5)) * 2048;
      const int rr = samp ? s : (s & 31);
      float* kout = nullptr;
      if (region == 1) {
        if (LAYER == 0) kout = p.out + (samp ? OFF_K0S + (size_t)ts * 1024 : OFF_K0P + (size_t)t * 1024) + f0;
        else            kout = p.out + (samp ? OFF_K1S + (size_t)ts * 1024 : OFF_K1P + (size_t)t * 1024) + f0;
      }
#pragma unroll
      for (int mt = 0; mt < 4; ++mt) {
        float v[4];
        if (LAYER == 0) {
          const float4 g4 = *(const float4*)(gn + mt * 16 + lq * 4);
          v[0] = acc[mt][nt][0] * rinv * g4.x; v[1] = acc[mt][nt][1] * rinv * g4.y;
          v[2] = acc[mt][nt][2] * rinv * g4.z; v[3] = acc[mt][nt][3] * rinv * g4.w;
        } else {
#pragma unroll
          for (int j = 0; j < 4; ++j) v[j] = acc[mt][nt][j];
        }
        if (region == 1) *(float4*)(kout + mt * 16 + lq * 4) = make_float4(v[0], v[1], v[2], v[3]);
        uint2 pk;
        pk.x = pk2(v[0] * qscale, v[1] * qscale);
        pk.y = pk2(v[2] * qscale, v[3] * qscale);
        *(uint2*)(fb + (mt * 64 + (lq >> 1) * 32 + rr) * 8 + (lq & 1) * 4) = pk;
      }
    } else if (region == 2) {
      float* vout;
      if (LAYER == 0) vout = p.out + (samp ? OFF_V0S + (size_t)ts * 1024 : OFF_V0P + (size_t)t * 1024) + f0;
      else            vout = p.out + (samp ? OFF_V1S + (size_t)ts * 1024 : OFF_V1P + (size_t)t * 1024) + f0;
      const int kk = samp ? s : (s & 31);
      const int sv = kk >> 4, hh = (kk >> 2) & 1, jf = ((kk >> 3) & 1) * 4 + (kk & 3);
      u16* vb;
      int dbase;
      if (LAYER == 0) {
        const int h = f0 >> 7;
        dbase = f0 & 127;
        vb = samp ? (u16*)(ws + WS_VFS) + (size_t)(b * 8 + h) * 4096
                  : (u16*)(ws + WS_VF) + ((size_t)(b * 8 + h) * 64 + (s >> 5)) * 4096;
      } else {
        dbase = 0;
        vb = samp ? (u16*)(ws + WS_VFS) + (size_t)(b * 16 + hc) * 2048
                  : (u16*)(ws + WS_VF) + ((size_t)(b * 16 + hc) * 64 + (s >> 5)) * 2048;
      }
#pragma unroll
      for (int mt = 0; mt < 4; ++mt) {
        *(float4*)(vout + mt * 16 + lq * 4) = make_float4(acc[mt][nt][0], acc[mt][nt][1], acc[mt][nt][2], acc[mt][nt][3]);
#pragma unroll
        for (int j = 0; j < 4; ++j) {
          const int d = dbase + mt * 16 + lq * 4 + j;
          vb[((d >> 5) * 2 + sv) * 512 + (hh * 32 + (d & 31)) * 8 + jf] = f2bf(acc[mt][nt][j]);
        }
      }
    } else {
      u16* sg = (u16*)(ws + WS_SG) + (size_t)t * 1024 + f0;
#pragma unroll
      for (int mt = 0; mt < 4; ++mt) {
        float v[4];
#pragma unroll
        for (int j = 0; j < 4; ++j) {
          const float x = acc[mt][nt][j];
          v[j] = x * __builtin_amdgcn_rcpf(1.f + __expf(-x));
        }
        uint2 pk;
        pk.x = pk2(v[0], v[1]);
        pk.y = pk2(v[2], v[3]);
        *(uint2*)(sg + mt * 16 + lq * 4) = pk;
      }
    }
  }
}

template <int LAYER>
DEV void outproj_epilogue(const Params& p, f32x4 (&acc)[4][2], int n0, int m0) {
  const int tid = opaque_tid(), lane = tid & 63, w = tid >> 6;
  const int wa = w & 1, wb = w >> 1;
  const int lr = lane & 15, lq = lane >> 4;
#pragma unroll
  for (int nt = 0; nt < 2; ++nt) {
    const int t = m0 + wb * 32 + nt * 16 + lr;
    float* yo = p.out + (size_t)t * 1024 + n0 + wa * 64 + lq * 4;
    const float* xi;
    if (LAYER == 0)
      xi = (t >= NTOK_P ? p.x_sample + (size_t)(t - NTOK_P) * 1024 : p.x_prompt + (size_t)t * 1024) + n0 + wa * 64 + lq * 4;
    else
      xi = yo;
#pragma unroll
    for (int mt = 0; mt < 4; ++mt) {
      const float4 xv = *(const float4*)(xi + mt * 16);
      *(float4*)(yo + mt * 16) = make_float4(xv.x + acc[mt][nt][0], xv.y + acc[mt][nt][1], xv.z + acc[mt][nt][2], xv.w + acc[mt][nt][3]);
    }
  }
}

DEV void transpose_tile(const float* __restrict__ W, int N, u16* __restrict__ Wt, int k0, int n0, float* ldsf) {
  const int tid = opaque_tid();
#pragma unroll
  for (int i = 0; i < 2; ++i) {
    const int idx = tid + 512 * i;
    const int kr = idx >> 4, c4 = idx & 15;
    const float4 v = *(const float4*)(W + (size_t)(k0 + kr) * N + n0 + c4 * 4);
    float* d = ldsf + kr * 65 + c4 * 4;
    d[0] = v.x; d[1] = v.y; d[2] = v.z; d[3] = v.w;
  }
  __syncthreads();
  {
    const int n = tid >> 3, kc = tid & 7;
    float f[8];
#pragma unroll
    for (int j = 0; j < 8; ++j) f[j] = ldsf[(kc * 8 + j) * 65 + n];
    uint4 o = make_uint4(pk2(f[0], f[1]), pk2(f[2], f[3]), pk2(f[4], f[5]), pk2(f[6], f[7]));
    *(uint4*)(Wt + (size_t)(n0 + n) * 1024 + k0 + kc * 8) = o;
  }
  __syncthreads();
}

template <class SrcOf>
DEV void norm_rows(SrcOf src_of, const float* __restrict__ g, u16* __restrict__ dst, int row0, int stride, int lane) {
  float4 cur[4], nxt[4];
  if (row0 < NTOK) {
    const float4* s = (const float4*)src_of(row0);
#pragma unroll
    for (int i = 0; i < 4; ++i) cur[i] = s[lane + 64 * i];
  }
  for (int row = row0; row < NTOK; row += stride) {
    const int nr = row + stride;
    if (nr < NTOK) {
      const float4* s = (const float4*)src_of(nr);
#pragma unroll
      for (int i = 0; i < 4; ++i) nxt[i] = s[lane + 64 * i];
    }
    float ss = 0.f;
#pragma unroll
    for (int i = 0; i < 4; ++i) ss += cur[i].x * cur[i].x + cur[i].y * cur[i].y + cur[i].z * cur[i].z + cur[i].w * cur[i].w;
    ss = wave_sum(ss);
    const float rn = rsqrtf(ss * (1.f / 1024.f) + 1e-6f);
    uint2* d = (uint2*)(dst + (size_t)row * 1024);
#pragma unroll
    for (int i = 0; i < 4; ++i) {
      const float4 gg = ((const float4*)g)[lane + 64 * i];
      uint2 o;
      o.x = pk2(cur[i].x * rn * gg.x, cur[i].y * rn * gg.y);
      o.y = pk2(cur[i].z * rn * gg.z, cur[i].w * rn * gg.w);
      d[lane + 64 * i] = o;
    }
#pragma unroll
    for (int i = 0; i < 4; ++i) cur[i] = nxt[i];
  }
}

DEV void attn0_ptile(const f32x16& S, float base, float slope2, bool first_half_only, float& l, unsigned (&pw)[8]) {
#pragma unroll
  for (int i = 0; i < 16; i += 2) {
    const float ca = (float)((i & 3) + 8 * (i >> 2));
    const float cb = (float)(((i + 1) & 3) + 8 * ((i + 1) >> 2));
    float ea = ex2(fmaf(-slope2, fabsf(base - ca), S[i]));
    float eb = ex2(fmaf(-slope2, fabsf(base - cb), S[i + 1]));
    if (first_half_only && i >= 8) { ea = 0.f; eb = 0.f; }
    l += ea + eb;
    pw[i >> 1] = pk2(ea, eb);
  }
}

DEV void attn0_gate_load(const Params& p, size_t t, int h, int hh, uint2 (&gt)[4][4]) {
  const u16* sgp = (const u16*)(p.ws + WS_SG) + t * 1024 + h * 128;
#pragma unroll
  for (int db = 0; db < 4; ++db)
#pragma unroll
    for (int g = 0; g < 4; ++g) gt[db][g] = *(const uint2*)(sgp + db * 32 + 8 * g + 4 * hh);
}
DEV void attn0_finish(const Params& p, f32x16 (&O)[4], size_t t, int h, int hh, bool valid, const uint2 (&gtp)[4][4]) {
  float ss = 0.f;
#pragma unroll
  for (int db = 0; db < 4; ++db)
#pragma unroll
    for (int i = 0; i < 16; ++i) ss += O[db][i] * O[db][i];
  ss += __shfl_xor(ss, 32);
  const float rn = rsqrtf(ss * (1.f / 128.f) + 1e-6f) * 0.8f;
  if (valid) {
    u16* ogp = (u16*)(p.ws + WS_ACT) + t * 1024 + h * 128;
#pragma unroll
    for (int db = 0; db < 4; ++db)
#pragma unroll
      for (int g = 0; g < 4; ++g) {
        const int d = db * 32 + 8 * g + 4 * hh;
        const float4 gn = *(const float4*)(p.subln_g + d);
        const uint2 gt = gtp[db][g];
        uint2 o;
        o.x = pk2(O[db][4 * g + 0] * rn * gn.x * bflo(gt.x), O[db][4 * g + 1] * rn * gn.y * bfhi(gt.x));
        o.y = pk2(O[db][4 * g + 2] * rn * gn.z * bflo(gt.y), O[db][4 * g + 3] * rn * gn.w * bfhi(gt.y));
        *(uint2*)(ogp + d) = o;
      }
  }
}

DEV void attn0_prompt(const Params& p, int b, int h, int cp, int kt0, char* lds, int lane, int w, float neg_lam) {
  const int pair = w >> 1, comp = w & 1;
  const int r = lane & 31, hh = lane >> 5;
  const int qblk = 4 * cp + pair;
  const int my_nt = 2 * ((qblk >> 1) + 1);
  const int NT = 4 * cp + 4;
  char* ws = p.ws;
  typedef __attribute__((address_space(3))) unsigned lds_u32;
  typedef const __attribute__((address_space(1))) unsigned glb_u32;
  char* qst = lds + 65536 + w * 8192 + lane * 16;
  {
    const u16* qb = (const u16*)(ws + WS_QF) + ((size_t)(b * 16 + 2 * h + comp) * 64 + qblk) * 2048 + lane * 8;
#pragma unroll
    for (int s = 0; s < 4; ++s) __builtin_amdgcn_global_load_lds((glb_u32*)(qb + s * 512), (lds_u32*)(qst + s * 1024), 16, 0, 0);
  }
  const u16* src0;
  size_t tstride;
  if (w < 4) { src0 = (const u16*)(ws + WS_KF) + (size_t)(b * 16 + 2 * h + (w >> 1)) * 64 * 2048 + ((2 * w) & 3) * 512 + lane * 8; tstride = 2048; }
  else       { src0 = (const u16*)(ws + WS_VF) + (size_t)(b * 8 + h) * 64 * 4096 + (2 * w - 8) * 512 + lane * 8; tstride = 4096; }
  char* dst0 = lds + (2 * w) * 1024 + lane * 16;
#define ATT_DMA(kt) do { const u16* s_ = src0 + (size_t)(kt) * tstride; char* d_ = dst0 + ((kt) & 3) * 16384; \
    __builtin_amdgcn_global_load_lds((glb_u32*)s_, (lds_u32*)d_, 16, 0, 0); \
    __builtin_amdgcn_global_load_lds((glb_u32*)(s_ + 512), (lds_u32*)(d_ + 1024), 16, 0, 0); } while (0)
  ATT_DMA(kt0); ATT_DMA(kt0 + 1); ATT_DMA(kt0 + 2);
  asm volatile("s_waitcnt vmcnt(6)" ::: "memory");
  bf16x8 qf[4];
#pragma unroll
  for (int s = 0; s < 4; ++s) qf[s] = *(const bf16x8*)(qst + s * 1024);
  f32x16 O[4];
#pragma unroll
  for (int db = 0; db < 4; ++db)
#pragma unroll
    for (int i = 0; i < 16; ++i) O[db][i] = 0.f;
  float l = 0.f;
  const float slope2 = exp2f(-(float)(h + 1)) * LOG2E;
  const float qposf = (float)(qblk * 32 + r);
  for (int kt = kt0; kt < NT; ++kt) {
    if (kt + 2 < NT) asm volatile("s_waitcnt vmcnt(4) lgkmcnt(0)" ::: "memory");
    else if (kt + 1 < NT) asm volatile("s_waitcnt vmcnt(2) lgkmcnt(0)" ::: "memory");
    else asm volatile("s_waitcnt vmcnt(0) lgkmcnt(0)" ::: "memory");
    __builtin_amdgcn_s_barrier();
    asm volatile("" ::: "memory");
    if (kt + 3 < NT) ATT_DMA(kt + 3);
    if (kt < my_nt) {
      const char* img = lds + (kt & 3) * 16384 + lane * 16;
      bf16x8 kf[4], vf[4][2];
#pragma unroll
      for (int s = 0; s < 4; ++s) kf[s] = *(const bf16x8*)(img + (comp * 4 + s) * 1024);
      __builtin_amdgcn_sched_barrier(0);
      f32x16 S;
#pragma unroll
      for (int i = 0; i < 16; ++i) S[i] = 0.f;
#pragma unroll
      for (int s = 0; s < 4; ++s) S = __builtin_amdgcn_mfma_f32_32x32x16_bf16(kf[s], qf[s], S, 0, 0, 0);
      __builtin_amdgcn_sched_barrier(0);
#pragma unroll
      for (int db = 0; db < 4; ++db)
#pragma unroll
        for (int s = 0; s < 2; ++s) vf[db][s] = *(const bf16x8*)(img + (8 + db * 2 + s) * 1024);
      __builtin_amdgcn_sched_barrier(0);
      unsigned pw[8];
      attn0_ptile(S, qposf - (float)(kt * 32 + 4 * hh), slope2, false, l, pw);
#pragma unroll
      for (int s = 0; s < 2; ++s) {
        const bf16x8 pf = mk8(pw[4 * s], pw[4 * s + 1], pw[4 * s + 2], pw[4 * s + 3]);
#pragma unroll
        for (int db = 0; db < 4; ++db) O[db] = __builtin_amdgcn_mfma_f32_32x32x16_bf16(vf[db][s], pf, O[db], 0, 0, 0);
      }
    }
  }
#undef ATT_DMA
  l += __shfl_xor(l, 32);
  float* ldsx = (float*)(lds + 65536 + pair * 16384);
  const size_t trow = (size_t)b * 2048 + qblk * 32 + r;
  uint2 gtp[4][4];
  if (comp == 0) attn0_gate_load(p, trow, h, hh, gtp);
  if (comp == 1) {
    const float c2 = neg_lam / l;
#pragma unroll
    for (int db = 0; db < 4; ++db)
#pragma unroll
      for (int i = 0; i < 16; ++i) ldsx[(db * 16 + i) * 64 + lane] = c2 * O[db][i];
  }
  __syncthreads();
  if (comp == 0) {
    const float c1 = 1.f / l;
#pragma unroll
    for (int db = 0; db < 4; ++db)
#pragma unroll
      for (int i = 0; i < 16; ++i) O[db][i] = c1 * O[db][i] + ldsx[(db * 16 + i) * 64 + lane];
    attn0_finish(p, O, trow, h, hh, true, gtp);
  }
}

DEV void attn0_sample(const Params& p, int b, int h, char* lds, int lane, int w, float neg_lam) {
  const int pair = w >> 1, comp = w & 1;
  const int r = lane & 31, hh = lane >> 5;
  char* ws = p.ws;
  bf16x8 qf[4];
  {
    const u16* qb = (const u16*)(ws + WS_QFS) + (size_t)(b * 16 + 2 * h + comp) * 2048;
#pragma unroll
    for (int s = 0; s < 4; ++s) qf[s] = *(const bf16x8*)(qb + s * 512 + lane * 8);
  }
  const int kt0 = pair * 16, kt1 = kt0 + 16 + (pair == 3 ? 1 : 0);
  const float slope2 = exp2f(-(float)(h + 1)) * LOG2E;
  const float qposf = (float)(2048 + r);
  bf16x8 kf[4], vf[4][2];
  auto load_k = [&](int kt) {
    if (kt < 64) {
      const float* base = p.ck0 + (((size_t)b * 2048 + kt * 32 + r) * 8 + h) * 128 + comp * 64 + 8 * hh;
#pragma unroll
      for (int s = 0; s < 4; ++s) {
        const float4 u0 = *(const float4*)(base + 16 * s);
        const float4 u1 = *(const float4*)(base + 16 * s + 4);
        kf[s] = mk8(pk2(u0.x, u0.y), pk2(u0.z, u0.w), pk2(u1.x, u1.y), pk2(u1.z, u1.w));
      }
    } else {
      const u16* kb = (const u16*)(ws + WS_KFS) + (size_t)(b * 16 + 2 * h + comp) * 2048;
#pragma unroll
      for (int s = 0; s < 4; ++s) kf[s] = *(const bf16x8*)(kb + s * 512 + lane * 8);
    }
  };
  auto load_v = [&](int kt) {
    if (kt < 64) {
      const float* base = p.cv0 + (((size_t)b * 2048 + kt * 32 + 4 * hh) * 8 + h) * 128 + r;
#pragma unroll
      for (int db = 0; db < 4; ++db)
#pragma unroll
        for (int s = 0; s < 2; ++s) {
          float f[8];
#pragma unroll
          for (int j = 0; j < 8; ++j) f[j] = base[(size_t)(16 * s + 8 * (j >> 2) + (j & 3)) * 1024 + db * 32];
          vf[db][s] = mk8(pk2(f[0], f[1]), pk2(f[2], f[3]), pk2(f[4], f[5]), pk2(f[6], f[7]));
        }
    } else {
      const u16* vb = (const u16*)(ws + WS_VFS) + (size_t)(b * 8 + h) * 4096;
#pragma unroll
      for (int db = 0; db < 4; ++db)
#pragma unroll
        for (int s = 0; s < 2; ++s) vf[db][s] = *(const bf16x8*)(vb + (db * 2 + s) * 512 + lane * 8);
    }
  };
  f32x16 O[4];
#pragma unroll
  for (int db = 0; db < 4; ++db)
#pragma unroll
    for (int i = 0; i < 16; ++i) O[db][i] = 0.f;
  float l = 0.f;
  load_k(kt0);
  load_v(kt0);
  for (int kt = kt0; kt < kt1; ++kt) {
    f32x16 S;
#pragma unroll
    for (int i = 0; i < 16; ++i) S[i] = 0.f;
#pragma unroll
    for (int s = 0; s < 4; ++s) S = __builtin_amdgcn_mfma_f32_32x32x16_bf16(kf[s], qf[s], S, 0, 0, 0);
    if (kt + 1 < kt1) load_k(kt + 1);
    unsigned pw[8];
    attn0_ptile(S, qposf - (float)(kt * 32 + 4 * hh), slope2, kt == 64, l, pw);
#pragma unroll
    for (int s = 0; s < 2; ++s) {
      const bf16x8 pf = mk8(pw[4 * s], pw[4 * s + 1], pw[4 * s + 2], pw[4 * s + 3]);
#pragma unroll
      for (int db = 0; db < 4; ++db) O[db] = __builtin_amdgcn_mfma_f32_32x32x16_bf16(vf[db][s], pf, O[db], 0, 0, 0);
    }
    if (kt + 1 < kt1) load_v(kt + 1);
  }
  float* slot = (float*)lds;
  float* lsum = (float*)(lds + 131072);
#pragma unroll
  for (int db = 0; db < 4; ++db)
#pragma unroll
    for (int i = 0; i < 16; ++i) slot[(w * 64 + db * 16 + i) * 64 + lane] = O[db][i];
  lsum[w * 64 + lane] = l;
  __syncthreads();
  if (w == 0) {
    float l1 = 0.f, l2 = 0.f;
#pragma unroll
    for (int q = 0; q < 4; ++q) { l1 += lsum[(2 * q) * 64 + lane]; l2 += lsum[(2 * q + 1) * 64 + lane]; }
    l1 += __shfl_xor(l1, 32);
    l2 += __shfl_xor(l2, 32);
    const float c1 = 1.f / l1, c2 = neg_lam / l2;
#pragma unroll
    for (int db = 0; db < 4; ++db)
#pragma unroll
      for (int i = 0; i < 16; ++i) {
        float o1 = 0.f, o2 = 0.f;
#pragma unroll
        for (int q = 0; q < 4; ++q) {
          o1 += slot[((2 * q) * 64 + db * 16 + i) * 64 + lane];
          o2 += slot[((2 * q + 1) * 64 + db * 16 + i) * 64 + lane];
        }
        O[db][i] = c1 * o1 + c2 * o2;
      }
    uint2 gtp[4][4];
    attn0_gate_load(p, (size_t)(NTOK_P + b * 16 + (r & 15)), h, hh, gtp);
    attn0_finish(p, O, (size_t)(NTOK_P + b * 16 + r), h, hh, r < 16, gtp);
  }
}

template <bool SAMPLE>
DEV void attn1_run(const Params& p, int b, int h, int qblk, int lane, char* scr) {
  const int r = lane & 31, hh = lane >> 5;
  char* ws = p.ws;
  bf16x8 qf[4];
  {
    const u16* qb = SAMPLE ? (const u16*)(ws + WS_QFS) + (size_t)(b * 16 + h) * 2048
                           : (const u16*)(ws + WS_QF) + ((size_t)(b * 16 + h) * 64 + qblk) * 2048;
#pragma unroll
    for (int s = 0; s < 4; ++s) qf[s] = *(const bf16x8*)(qb + s * 512 + lane * 8);
  }
  const u16* kfb = (const u16*)(ws + WS_KF) + (size_t)(b * 16 + h) * 64 * 2048;
  const u16* vfb = (const u16*)(ws + WS_VF) + (size_t)(b * 16 + h) * 64 * 2048;
  const int ntot = SAMPLE ? 65 : (qblk + 1);
  auto load_k = [&](int it, bf16x8 (&kf)[4]) {
    if (SAMPLE && it > 0) {
      const int kt = 64 - it;
      const float* base = p.ck1 + (((size_t)b * 2048 + kt * 32 + r) * 16 + h) * 64 + 8 * hh;
#pragma unroll
      for (int s = 0; s < 4; ++s) {
        const float4 u0 = *(const float4*)(base + 16 * s);
        const float4 u1 = *(const float4*)(base + 16 * s + 4);
        kf[s] = mk8(pk2(u0.x, u0.y), pk2(u0.z, u0.w), pk2(u1.x, u1.y), pk2(u1.z, u1.w));
      }
    } else if (SAMPLE) {
      const u16* kb = (const u16*)(ws + WS_KFS) + (size_t)(b * 16 + h) * 2048;
#pragma unroll
      for (int s = 0; s < 4; ++s) kf[s] = *(const bf16x8*)(kb + s * 512 + lane * 8);
    } else {
      const u16* kb = kfb + (size_t)(qblk - it) * 2048;
#pragma unroll
      for (int s = 0; s < 4; ++s) kf[s] = *(const bf16x8*)(kb + s * 512 + lane * 8);
    }
  };
  auto load_v = [&](int it, bf16x8 (&vf)[2][2]) {
    if (SAMPLE && it > 0) {
      const int kt = 64 - it;
      const float* base = p.cv1 + (((size_t)b * 2048 + kt * 32 + 4 * hh) * 16 + h) * 64 + r;
#pragma unroll
      for (int db = 0; db < 2; ++db)
#pragma unroll
        for (int s = 0; s < 2; ++s) {
          float f[8];
#pragma unroll
          for (int j = 0; j < 8; ++j) f[j] = base[(size_t)(16 * s + 8 * (j >> 2) + (j & 3)) * 1024 + db * 32];
          vf[db][s] = mk8(pk2(f[0], f[1]), pk2(f[2], f[3]), pk2(f[4], f[5]), pk2(f[6], f[7]));
        }
    } else if (SAMPLE) {
      const u16* vb = (const u16*)(ws + WS_VFS) + (size_t)(b * 16 + h) * 2048;
#pragma unroll
      for (int db = 0; db < 2; ++db)
#pragma unroll
        for (int s = 0; s < 2; ++s) vf[db][s] = *(const bf16x8*)(vb + (db * 2 + s) * 512 + lane * 8);
    } else {
      const u16* vb = vfb + (size_t)(qblk - it) * 2048;
#pragma unroll
      for (int db = 0; db < 2; ++db)
#pragma unroll
        for (int s = 0; s < 2; ++s) vf[db][s] = *(const bf16x8*)(vb + (db * 2 + s) * 512 + lane * 8);
    }
  };

  f32x16 O[2];
#pragma unroll
  for (int db = 0; db < 2; ++db)
#pragma unroll
    for (int i = 0; i < 16; ++i) O[db][i] = 0.f;
  float carry = 0.f;
  const bool qvalid = !SAMPLE || r < 16;

  auto process = [&](int it, bf16x8 (&kf)[4], bf16x8 (&vf)[2][2]) -> bool {
    f32x16 S;
#pragma unroll
    for (int i = 0; i < 16; ++i) S[i] = 0.f;
#pragma unroll
    for (int s = 0; s < 4; ++s) S = __builtin_amdgcn_mfma_f32_32x32x16_bf16(kf[s], qf[s], S, 0, 0, 0);
    if (it + 2 < ntot) load_k(it + 2, kf);
    const int thr = (it == 0) ? (r - 4 * hh) : 1000;
    float x[16], lb[16];
#pragma unroll
    for (int i = 0; i < 16; ++i) {
      const int ci = (i & 3) + 8 * (i >> 2);
      const float z2 = S[i];
      const float e = ex2(z2);
      const float L = lg2(1.f + e);
      const bool valid = ci < thr;
      x[i] = valid ? -L : 0.f;
      lb[i] = z2 - L;
    }
    float T[4], Tp[4];
#pragma unroll
    for (int g = 0; g < 4; ++g) {
      T[g] = (x[4 * g] + x[4 * g + 1]) + (x[4 * g + 2] + x[4 * g + 3]);
      Tp[g] = __shfl_xor(T[g], 32);
    }
    float su[4];
    su[3] = 0.f;
    su[2] = T[3] + Tp[3];
    su[1] = su[2] + (T[2] + Tp[2]);
    su[0] = su[1] + (T[1] + Tp[1]);
    const float total = su[0] + (T[0] + Tp[0]);
    unsigned pw[8];
#pragma unroll
    for (int g = 0; g < 4; ++g) {
      const float gs = carry + su[g] + (hh == 0 ? Tp[g] : 0.f);
      const float a3 = gs;
      const float a2 = a3 + x[4 * g + 3];
      const float a1 = a2 + x[4 * g + 2];
      const float a0 = a1 + x[4 * g + 1];
      const int c0 = 8 * g;
      const float w0 = (c0 + 0 < thr) ? ex2(lb[4 * g + 0] + a0) : 0.f;
      const float w1 = (c0 + 1 < thr) ? ex2(lb[4 * g + 1] + a1) : 0.f;
      const float w2 = (c0 + 2 < thr) ? ex2(lb[4 * g + 2] + a2) : 0.f;
      const float w3 = (c0 + 3 < thr) ? ex2(lb[4 * g + 3] + a3) : 0.f;
      pw[2 * g] = pk2(w0, w1);
      pw[2 * g + 1] = pk2(w2, w3);
    }
    carry += total;
#pragma unroll
    for (int s = 0; s < 2; ++s) {
      const bf16x8 pf = mk8(pw[4 * s], pw[4 * s + 1], pw[4 * s + 2], pw[4 * s + 3]);
#pragma unroll
      for (int db = 0; db < 2; ++db) O[db] = __builtin_amdgcn_mfma_f32_32x32x16_bf16(vf[db][s], pf, O[db], 0, 0, 0);
    }
    if (__all((carry < -64.f) || !qvalid)) return true;
    if (it + 2 < ntot) load_v(it + 2, vf);
    return false;
  };

  bf16x8 kA[4], kB[4], vA[2][2], vB[2][2];
  load_k(0, kA);
  load_v(0, vA);
  if (ntot > 1) { load_k(1, kB); load_v(1, vB); }
  for (int it = 0; it < ntot; it += 2) {
    if (process(it, kA, vA)) break;
    if (it + 1 >= ntot) break;
    if (process(it + 1, kB, vB)) break;
  }
  if (!SAMPLE) {
    const size_t t0 = (size_t)b * 2048 + qblk * 32;
    const u16* sgp = (const u16*)(ws + WS_SG) + t0 * 1024 + h * 64;
    u16* ogp = (u16*)(ws + WS_ACT) + t0 * 1024 + h * 64;
    const int tk = lane >> 3, ck = lane & 7;
#pragma unroll
    for (int q = 0; q < 4; ++q) {
      const uint4 gv = *(const uint4*)(sgp + (size_t)(q * 8 + tk) * 1024 + ck * 8);
      *(uint4*)(scr + (q * 8 + tk) * 144 + ck * 16) = gv;
    }
    asm volatile("s_waitcnt lgkmcnt(0)" ::: "memory");
#pragma unroll
    for (int db = 0; db < 2; ++db)
#pragma unroll
      for (int g = 0; g < 4; ++g) {
        char* cell = scr + r * 144 + (db * 32 + 8 * g + 4 * hh) * 2;
        const uint2 gt = *(const uint2*)cell;
        uint2 o;
        o.x = pk2(O[db][4 * g + 0] * bflo(gt.x), O[db][4 * g + 1] * bfhi(gt.x));
        o.y = pk2(O[db][4 * g + 2] * bflo(gt.y), O[db][4 * g + 3] * bfhi(gt.y));
        *(uint2*)cell = o;
      }
    asm volatile("s_waitcnt lgkmcnt(0)" ::: "memory");
#pragma unroll
    for (int q = 0; q < 4; ++q) {
      const uint4 ov = *(const uint4*)(scr + (q * 8 + tk) * 144 + ck * 16);
      *(uint4*)(ogp + (size_t)(q * 8 + tk) * 1024 + ck * 8) = ov;
    }
  } else if (qvalid) {
    const size_t t = (size_t)(NTOK_P + b * 16 + r);
    const u16* sgp = (const u16*)(ws + WS_SG) + t * 1024 + h * 64;
    u16* ogp = (u16*)(ws + WS_ACT) + t * 1024 + h * 64;
#pragma unroll
    for (int db = 0; db < 2; ++db)
#pragma unroll
      for (int g = 0; g < 4; ++g) {
        const int d = db * 32 + 8 * g + 4 * hh;
        const uint2 gt = *(const uint2*)(sgp + d);
        uint2 o;
        o.x = pk2(O[db][4 * g + 0] * bflo(gt.x), O[db][4 * g + 1] * bfhi(gt.x));
        o.y = pk2(O[db][4 * g + 2] * bflo(gt.y), O[db][4 * g + 3] * bfhi(gt.y));
        *(uint2*)(ogp + d) = o;
      }
  }
}

#define XB_TMO      128
#define XB_XCNT(j)  (256  + 64 * (j))
#define XB_XSUB(j)  (1280 + 64 * (j))
#define XB_XGEN(j)  (2304 + 64 * (j))
#define XB_TOP      3328
#define XB_TOPGEN   3392
#define XCD_BAR_WORDS 3456
#define XB_SPIN_CAP (1u << 18)
#define XB_LAS __attribute__((address_space(3)))
DEV unsigned xb_ld(unsigned* p)              { return __hip_atomic_load(p, __ATOMIC_RELAXED, __HIP_MEMORY_SCOPE_AGENT); }
DEV unsigned xb_add(unsigned* p, unsigned v) { return __hip_atomic_fetch_add(p, v, __ATOMIC_RELAXED, __HIP_MEMORY_SCOPE_AGENT); }
DEV unsigned xb_xcc_id() { return (unsigned)__builtin_amdgcn_s_getreg((3 << 11) | 20) & 0xFu; }
#define XB_SPIN(cond, bar) do { unsigned _sp = 0; while (cond) { __builtin_amdgcn_s_sleep(1); \
    if ((++_sp & 255u) == 0u) { if (xb_ld(&(bar)[XB_TMO])) break; if (_sp > XB_SPIN_CAP) { atomicAdd(&(bar)[XB_TMO], 1u); break; } } } } while (0)
struct XcdBarrier { unsigned* bar; unsigned x; volatile XB_LAS unsigned* st; };
DEV XcdBarrier xcd_barrier_post(unsigned* bar, volatile XB_LAS unsigned* st) {
  XcdBarrier b; b.bar = bar; b.x = xb_xcc_id(); b.st = st;
  if (threadIdx.x == 0) (void)xb_add(&bar[XB_XCNT(b.x)], 1u);
  return b;
}
DEV void xcd_barrier_complete(unsigned* bar, unsigned x, unsigned& nloc, unsigned& nx) {
  const unsigned G = gridDim.x * gridDim.y * gridDim.z;
  unsigned sum, cnt, mine, sp = 0u;
  for (;;) {
    sum = 0u; cnt = 0u; mine = 0u;
#pragma unroll
    for (unsigned j = 0; j < 16; ++j) { const unsigned c = xb_ld(&bar[XB_XCNT(j)]); sum += c; cnt += (c > 0u) ? 1u : 0u; mine = (j == x) ? c : mine; }
    if (sum == G) break;
    __builtin_amdgcn_s_sleep(1);
    if ((++sp & 255u) == 0u) { if (xb_ld(&bar[XB_TMO])) break; if (sp > XB_SPIN_CAP) { atomicAdd(&bar[XB_TMO], 1u); break; } }
  }
  nloc = mine > 0u ? mine : 1u; nx = cnt > 0u ? cnt : 1u;
}
DEV void xcd_barrier(const XcdBarrier& b) {
  asm volatile("s_waitcnt vmcnt(0)" ::: "memory");
  __syncthreads();
  if (threadIdx.x == 0) {
    unsigned* bar = b.bar;
    __builtin_amdgcn_s_waitcnt(0);
    unsigned nloc = b.st[0], nx = b.st[1];
    if (nloc == 0u) { xcd_barrier_complete(bar, b.x, nloc, nx); b.st[0] = nloc; b.st[1] = nx; }
    const unsigned old = xb_add(&bar[XB_XSUB(b.x)], 1u);
    const unsigned gen = old / nloc;
    if (old + 1u == (gen + 1u) * nloc) {
      __builtin_amdgcn_fence(__ATOMIC_RELEASE, "agent");
      asm volatile("s_waitcnt vmcnt(0)" ::: "memory");
      const unsigned og = xb_add(&bar[XB_TOP], 1u);
      const unsigned tg = og / nx;
      if (og + 1u == (tg + 1u) * nx) xb_add(&bar[XB_TOPGEN], 1u);
      else XB_SPIN(xb_ld(&bar[XB_TOPGEN]) == tg, bar);
      __builtin_amdgcn_fence(__ATOMIC_ACQUIRE, "agent");
      xb_add(&bar[XB_XGEN(b.x)], 1u);
      asm volatile("s_waitcnt vmcnt(0)" ::: "memory");
    } else {
      XB_SPIN(xb_ld(&bar[XB_XGEN(b.x)]) == gen, bar);
      __builtin_amdgcn_fence(__ATOMIC_ACQUIRE, "agent");
      asm volatile("s_waitcnt vmcnt(0)" ::: "memory");
    }
  }
  __syncthreads();
}

DEV int fetch_unit(unsigned* ctr, int lane) {
  unsigned v = 0;
  if (lane == 0) v = atomicAdd(ctr, 1u);
  return (int)__builtin_amdgcn_readfirstlane(v);
}

__global__ void __launch_bounds__(512, 2) fwd_megakernel(Params p) {
  extern __shared__ __attribute__((aligned(16))) char lds[];
  __shared__ unsigned s_misc[4];
#define s_unit (*(int*)&s_misc[0])
  cg::grid_group grid = cg::this_grid();
#define PHASE_IDS() int tid = threadIdx.x; asm volatile("" : "+v"(tid)); const int lane = tid & 63, w = tid >> 6; const int gw = bid * 8 + w; (void)lane; (void)gw;
  const int nblk = gridDim.x, bid = blockIdx.x;
  const int ngw = nblk * 8;
  char* ws = p.ws;
  unsigned* cnt = (unsigned*)(ws + WS_CNT);
  PG8_LAS unsigned char* ldsg = (PG8_LAS unsigned char*)lds;
  pg8::StaticOrder S;

  if (p.ws == nullptr) grid.sync();
  const XcdBarrier xbar = xcd_barrier_post((unsigned*)(ws + WS_BAR), (volatile XB_LAS unsigned*)&s_misc[1]);

  {
  PHASE_IDS();
  if (tid < 4) s_misc[tid] = 0u;
  {
    uint4* z = (uint4*)(ws + WS_QFS);
    for (int i = bid * 512 + tid; i < 98304; i += nblk * 512) z[i] = make_uint4(0, 0, 0, 0);
  }
  for (int id = bid; id < 2560; id += nblk) {
    if (id < 1024)      transpose_tile(p.w_in0, 4096, (u16*)(ws + WS_WT_IN0), (id >> 6) * 64, (id & 63) * 64, (float*)lds);
    else if (id < 1280) transpose_tile(p.w_out0, 1024, (u16*)(ws + WS_WT_OUT0), ((id - 1024) >> 4) * 64, ((id - 1024) & 15) * 64, (float*)lds);
    else if (id < 2304) transpose_tile(p.w_in1, 4096, (u16*)(ws + WS_WT_IN1), ((id - 1280) >> 6) * 64, ((id - 1280) & 63) * 64, (float*)lds);
    else                transpose_tile(p.w_out1, 1024, (u16*)(ws + WS_WT_OUT1), ((id - 2304) >> 4) * 64, ((id - 2304) & 15) * 64, (float*)lds);
  }
  norm_rows([&](int row) { return row < NTOK_P ? p.x_prompt + (size_t)row * 1024 : p.x_sample + (size_t)(row - NTOK_P) * 1024; },
            p.norm_g0, (u16*)(ws + WS_ACT), gw, ngw, lane);
  }
  xcd_barrier(xbar);

  {
    S.init(NTOK_P, 4096, nblk, bid);
    pg8::Gemm g{(const u16*)(ws + WS_ACT), (const u16*)(ws + WS_WT_IN0), NTOK_P, 4096, 1024};
    EpiIn<0> E{p, lds + pg8::STAGE_BYTES};
    pg8::gemm_phase(ldsg, g, S, E);
    for (int st = bid; st < 32; st += nblk) {
      f32x4 acc[4][2];
      gemm_tile((const u16*)(ws + WS_WT_IN0), (const u16*)(ws + WS_ACT), st * 128, NTOK_P, lds, acc);
      inproj_epilogue<0>(p, acc, st * 128, NTOK_P);
    }
  }
  xcd_barrier(xbar);

  {
    PHASE_IDS();
    float a1 = p.lq1[lane] * p.lk1[lane], a2 = p.lq2[lane] * p.lk2[lane];
    a1 = wave_sum(a1);
    a2 = wave_sum(a2);
    const float lam = __expf(a1) - __expf(a2) + 0.2f;
    const int wu = __builtin_amdgcn_readfirstlane(w);
    float gq = fabsf(p.q_norm[lane]), gk = fabsf(p.k_norm[lane]);
#pragma unroll
    for (int o = 32; o; o >>= 1) { gq = fmaxf(gq, __shfl_xor(gq, o)); gk = fmaxf(gk, __shfl_xor(gk, o)); }
    const float smax2 = 8.f * gq * gk * LOG2E * 1.02f;
    for (;;) {
      __syncthreads();
      if (tid == 0) s_unit = (int)atomicAdd(cnt + 0, 1u);
      __syncthreads();
      const int u = s_unit;
      if (u >= 64 + 2048) break;
      if (u < 64) attn0_sample(p, u >> 3, u & 7, lds, lane, wu, -lam);
      else {
        const int v = u - 64;
        const int hh_ = v & 7, cp_ = 15 - (v >> 7);
        const float dmin = (2.f * smax2 + 75.f) / (exp2f(-(float)(hh_ + 1)) * LOG2E);
        int kt0 = 0;
        if (dmin < 4096.f) {
          const int num = 128 * cp_ - 31 - (int)ceilf(dmin);
          if (num >= 0) kt0 = num / 32 + 1;
        }
        kt0 = __builtin_amdgcn_readfirstlane(kt0);
        attn0_prompt(p, (v & 127) >> 3, hh_, cp_, kt0, lds, lane, wu, -lam);
      }
    }
  }
  xcd_barrier(xbar);

  {
    S.init(NTOK_P, 1024, nblk, bid);
    pg8::Gemm g{(const u16*)(ws + WS_ACT), (const u16*)(ws + WS_WT_OUT0), NTOK_P, 1024, 1024};
    EpiOut<0> E{p};
    pg8::gemm_phase(ldsg, g, S, E);
    for (int st = bid; st < 8; st += nblk) {
      f32x4 acc[4][2];
      gemm_tile((const u16*)(ws + WS_WT_OUT0), (const u16*)(ws + WS_ACT), st * 128, NTOK_P, lds, acc);
      outproj_epilogue<0>(p, acc, st * 128, NTOK_P);
    }
  }
  xcd_barrier(xbar);

  {
    PHASE_IDS();
    norm_rows([&](int row) { return (const float*)(p.out + (size_t)row * 1024); }, p.norm_g1, (u16*)(ws + WS_ACT), gw, ngw, lane);
  }
  xcd_barrier(xbar);

  {
    S.init(NTOK_P, 4096, nblk, bid);
    pg8::Gemm g{(const u16*)(ws + WS_ACT), (const u16*)(ws + WS_WT_IN1), NTOK_P, 4096, 1024};
    EpiIn<1> E{p, lds + pg8::STAGE_BYTES};
    pg8::gemm_phase(ldsg, g, S, E);
    for (int st = bid; st < 32; st += nblk) {
      f32x4 acc[4][2];
      gemm_tile((const u16*)(ws + WS_WT_IN1), (const u16*)(ws + WS_ACT), st * 128, NTOK_P, lds, acc);
      inproj_epilogue<1>(p, acc, st * 128, NTOK_P);
    }
  }
  xcd_barrier(xbar);

  {
  PHASE_IDS();
  for (int u = gw; u < 128 + 16384; u += ngw) {
    if (u < 128) attn1_run<true>(p, u >> 4, u & 15, 0, lane, lds + w * 8192);
    else {
      const int v = u - 128;
      attn1_run<false>(p, (v & 255) >> 4, v & 15, 63 - (v >> 8), lane, lds + w * 8192);
    }
  }
  }
  xcd_barrier(xbar);

  {
    S.init(NTOK_P, 1024, nblk, bid);
    pg8::Gemm g{(const u16*)(ws + WS_ACT), (const u16*)(ws + WS_WT_OUT1), NTOK_P, 1024, 1024};
    EpiOut<1> E{p};
    pg8::gemm_phase(ldsg, g, S, E);
    for (int st = bid; st < 8; st += nblk) {
      f32x4 acc[4][2];
      gemm_tile((const u16*)(ws + WS_WT_OUT1), (const u16*)(ws + WS_ACT), st * 128, NTOK_P, lds, acc);
      outproj_epilogue<1>(p, acc, st * 128, NTOK_P);
    }
  }
}

extern "C" void kernel_launch(void* const* d_in, const int* in_sizes, int n_in, void* d_out, int out_size, void* d_ws,
                              size_t ws_size, hipStream_t stream) {
  Params p{};
  p.x_prompt = (const float*)d_in[0]; p.x_sample = (const float*)d_in[1];
  p.ck0 = (const float*)d_in[2]; p.cv0 = (const float*)d_in[3]; p.ck1 = (const float*)d_in[4]; p.cv1 = (const float*)d_in[5];
  p.norm_g0 = (const float*)d_in[6]; p.w_in0 = (const float*)d_in[7]; p.q_norm = (const float*)d_in[8]; p.k_norm = (const float*)d_in[9];
  p.lq1 = (const float*)d_in[10]; p.lk1 = (const float*)d_in[11]; p.lq2 = (const float*)d_in[12]; p.lk2 = (const float*)d_in[13];
  p.subln_g = (const float*)d_in[14]; p.w_out0 = (const float*)d_in[15]; p.norm_g1 = (const float*)d_in[16];
  p.w_in1 = (const float*)d_in[17]; p.w_out1 = (const float*)d_in[18];
  p.out = (float*)d_out;
  p.ws = (char*)d_ws;
  static int grid_blocks = 0;
  if (!grid_blocks) {
    int dev = 0, cus = 0, per_cu = 0;
    hipGetDevice(&dev);
    hipFuncSetAttribute((const void*)fwd_megakernel, hipFuncAttributeMaxDynamicSharedMemorySize, LDS_BYTES);
    hipDeviceGetAttribute(&cus, hipDeviceAttributeMultiprocessorCount, dev);
    hipOccupancyMaxActiveBlocksPerMultiprocessor(&per_cu, fwd_megakernel, 512, LDS_BYTES);
    if (per_cu < 1) per_cu = 1;
    if (per_cu > 1) per_cu = 1;
    grid_blocks = cus * per_cu;
  }
  hipMemsetAsync((char*)d_ws + WS_CNT, 0, 256 + XCD_BAR_WORDS * 4, stream);
  void* args[] = {&p};
  hipError_t e = hipLaunchCooperativeKernel((void*)fwd_megakernel, dim3(grid_blocks), dim3(512), args, LDS_BYTES, stream);
  if (e != hipSuccess) fprintf(stderr, "cooperative launch failed: %s (grid %d)\n", hipGetErrorString(e), grid_blocks);
}
```

```cpp
#include <hip/hip_runtime.h>
#include <hip/hip_cooperative_groups.h>
#include <cstdio>
namespace cg = cooperative_groups;

typedef __attribute__((ext_vector_type(8))) short bf16x8;
typedef __attribute__((ext_vector_type(4))) float f32x4;
typedef __attribute__((ext_vector_type(16))) float f32x16;
typedef __attribute__((ext_vector_type(2))) __bf16 bf2_t;
typedef unsigned short u16;

#define DEV __device__ __forceinline__

constexpr int NTOK_P = 32768;
constexpr int NTOK = 32896;
constexpr size_t NP = 33554432, NS = 131072;
constexpr size_t OFF_K0P = NP + NS, OFF_V0P = 2 * NP + NS, OFF_K0S = 3 * NP + NS, OFF_V0S = 3 * NP + 2 * NS;
constexpr size_t OFF_K1P = 3 * NP + 3 * NS, OFF_V1P = 4 * NP + 3 * NS, OFF_K1S = 5 * NP + 3 * NS, OFF_V1S = 5 * NP + 4 * NS;

constexpr size_t WS_WT_IN0 = 0;
constexpr size_t WS_WT_OUT0 = 8388608;
constexpr size_t WS_WT_IN1 = 10485760;
constexpr size_t WS_WT_OUT1 = 18874368;
constexpr size_t WS_ACT = 20971520;
constexpr size_t WS_SG = WS_ACT + 67371008;
constexpr size_t WS_QF = WS_SG + 67371008;
constexpr size_t WS_KF = WS_QF + 67108864;
constexpr size_t WS_VF = WS_KF + 67108864;
constexpr size_t WS_QFS = WS_VF + 67108864;
constexpr size_t WS_KFS = WS_QFS + 524288;
constexpr size_t WS_VFS = WS_KFS + 524288;
constexpr size_t WS_CNT = WS_VFS + 524288;
constexpr size_t WS_BAR = WS_CNT + 256;
constexpr int LDS_BYTES = 131072 + 18432;
constexpr float LOG2E = 1.4426950408889634f;

struct Params {
  const float* x_prompt; const float* x_sample;
  const float* ck0; const float* cv0; const float* ck1; const float* cv1;
  const float* norm_g0; const float* w_in0; const float* q_norm; const float* k_norm;
  const float* lq1; const float* lk1; const float* lq2; const float* lk2;
  const float* subln_g; const float* w_out0; const float* norm_g1; const float* w_in1; const float* w_out1;
  float* out;
  char* ws;
};

DEV unsigned pk2(float a, float b) { bf2_t v; v[0] = (__bf16)a; v[1] = (__bf16)b; return __builtin_bit_cast(unsigned, v); }
DEV u16 f2bf(float a) { __bf16 v = (__bf16)a; return __builtin_bit_cast(u16, v); }
DEV float bflo(unsigned v) { return __uint_as_float(v << 16); }
DEV float bfhi(unsigned v) { return __uint_as_float(v & 0xffff0000u); }
DEV bf16x8 mk8(unsigned a, unsigned b, unsigned c, unsigned d) { uint4 q = make_uint4(a, b, c, d); return __builtin_bit_cast(bf16x8, q); }
DEV float wave_sum(float v) {
#pragma unroll
  for (int o = 32; o; o >>= 1) v += __shfl_xor(v, o);
  return v;
}
DEV int opaque_tid() { int t = threadIdx.x; asm volatile("" : "+v"(t)); return t; }
DEV float ex2(float x) { return __builtin_amdgcn_exp2f(x); }
DEV float lg2(float x) { return __builtin_amdgcn_logf(x); }

typedef __attribute__((ext_vector_type(4))) unsigned u32x4_t;
DEV void nt_store_u4(void* ptr, uint4 v) { u32x4_t q = {v.x, v.y, v.z, v.w}; __builtin_nontemporal_store(q, (u32x4_t*)ptr); }
DEV void nt_store_f4(void* ptr, f32x4 v) { __builtin_nontemporal_store(v, (f32x4*)ptr); }

namespace pg8 {
#define PG8_LAS __attribute__((address_space(3)))
constexpr int BM = 256, BK = 64, HALF = 128, HTB = HALF * BK * 2, STAGE_BYTES = 8 * HTB, NXCD = 8, WGM = 8;
__device__ __forceinline__ int lds_byte(int r, int c) { const int st = (r >> 4) * 2 + (c >> 5), rr = r & 15, cc = c & 31, ob = rr * 64 + cc * 2; return st * 1024 + (ob ^ (((ob >> 9) & 1) << 5)); }
__device__ __forceinline__ void stage_rc(int b, int& R, int& C) { const int st = b / 1024, sb = b % 1024, swz = sb ^ (((sb >> 9) & 1) << 5); R = (st >> 1) * 16 + swz / 64; C = (st & 1) * 32 + (swz % 64) / 2; }
struct Unit { int pm, pn; };
struct Gemm { const u16* A; const u16* Bt; int M, N, K; };
struct StaticOrder {
  int nM, nN, nwg, G, c;
  __device__ void init(int M, int N, int G_, int c_) { nM = M / BM; nN = N / BM; nwg = nM * nN; G = G_; c = c_; }
  __device__ bool next(int i, Unit& u) const {
    const long L = (long)i * G + c; if (L >= nwg) return false;
    int wgid = (int)L; { const int q = nwg / NXCD, r = nwg % NXCD, xcd = wgid % NXCD, off = wgid / NXCD; wgid = (xcd < r ? xcd * (q + 1) : r * (q + 1) + (xcd - r) * q) + off; }
    const int nig = WGM * nN, gid = wgid / nig, fm = gid * WGM, gsz = (nM - fm) < WGM ? (nM - fm) : WGM;
    u.pm = fm + ((wgid % nig) % gsz); u.pn = (wgid % nig) / gsz; return true;
  }
};
template <class Epi>
__device__ __forceinline__ void gemm_phase(PG8_LAS unsigned char* lds, const Gemm g, const StaticOrder& S, const Epi& E) {
  const int tid = opaque_tid(), wid = __builtin_amdgcn_readfirstlane(tid >> 6), lane = tid & 63, wr = wid >> 2, wc = wid & 3, fr = lane & 15, fq = lane >> 4;
  const int K = g.K, nt = K / BK;
  unsigned voffA[2], voffB[2];
#pragma unroll
  for (int i = 0; i < 2; ++i) { int R, C; stage_rc(tid * 16 + i * 8192, R, C); const int Rb = ((R >> 5) << 6) + (R & 31);
    voffA[i] = (unsigned)(R * K + C) * 2u; voffB[i] = (unsigned)(Rb * K + C) * 2u; }
  const size_t kstep = (size_t)(BK * 2);
  const size_t hstep = (size_t)HALF * K * 2;
  const size_t hstepB = (size_t)32 * K * 2;
  const size_t tstep = 2 * hstep;
  const unsigned ldsw = (unsigned)wid * 1024u;
  const int aoff = lds_byte(wr * 64 + fr, fq * 8), boff = lds_byte(wc * 32 + fr, fq * 8);
#define PG8_SA(b, h) (((b) * 2 + (h)) * HTB)
#define PG8_SB(b, h) ((4 + (b) * 2 + (h)) * HTB)
#define PG8_STAGE(bufoff, gbase, voff) do { _Pragma("unroll") for (int _i = 0; _i < 2; ++_i) \
    __builtin_amdgcn_global_load_lds((const __attribute__((address_space(1))) unsigned*)((const char*)(gbase) + (voff)[_i]), (PG8_LAS unsigned*)(lds + (bufoff) + ldsw + _i * 8192), 16, 0, 0); } while (0)
#define PG8_LDA(dst, b, h) do { _Pragma("unroll") for (int m = 0; m < 4; ++m) _Pragma("unroll") for (int k = 0; k < 2; ++k) dst[m][k] = *(const PG8_LAS bf16x8*)(lds + PG8_SA(b, h) + aoff + m * 2048 + k * 1024); } while (0)
#define PG8_LDB(dst, b, h) do { _Pragma("unroll") for (int n = 0; n < 2; ++n) _Pragma("unroll") for (int k = 0; k < 2; ++k) dst[n][k] = *(const PG8_LAS bf16x8*)(lds + PG8_SB(b, h) + boff + n * 2048 + k * 1024); } while (0)
#define PG8_MMA(ai, bj, At, Bt) do { __builtin_amdgcn_s_setprio(1); _Pragma("unroll") for (int m = 0; m < 4; ++m) _Pragma("unroll") for (int n = 0; n < 2; ++n) _Pragma("unroll") for (int k = 0; k < 2; ++k) \
    acc[ai][bj][m][n] = __builtin_amdgcn_mfma_f32_16x16x32_bf16(Bt[n][k], At[m][k], acc[ai][bj][m][n], 0, 0, 0); __builtin_amdgcn_s_setprio(0); } while (0)
#define PG8_WAIT_V(n) asm volatile("s_waitcnt vmcnt(" #n ")" ::: "memory")
#define PG8_WAIT_L(n) asm volatile("s_waitcnt lgkmcnt(" #n ")" ::: "memory")
#define PG8_BAR __builtin_amdgcn_s_barrier()
#define PG8_SCHED __builtin_amdgcn_sched_barrier(0)
  Unit cur, nxt; int ui = 0;
  if (!S.next(0, cur)) return;
  f32x4 acc[2][2][4][2];
#pragma unroll
  for (int a = 0; a < 2; ++a)
#pragma unroll
    for (int b = 0; b < 2; ++b)
#pragma unroll
      for (int m = 0; m < 4; ++m)
#pragma unroll
        for (int n = 0; n < 2; ++n) acc[a][b][m][n] = (f32x4){0.f, 0.f, 0.f, 0.f};
  bf16x8 At[4][2], B0[2][2], B1[2][2];
  const char* cA = (const char*)g.A + (size_t)cur.pm * tstep; const char* cB = (const char*)g.Bt + (size_t)cur.pn * tstep;
  PG8_STAGE(PG8_SB(0, 0), cB, voffB); PG8_STAGE(PG8_SA(0, 0), cA, voffA); PG8_STAGE(PG8_SB(0, 1), cB + hstepB, voffB); PG8_STAGE(PG8_SA(0, 1), cA + hstep, voffA);
  if (wr == 1) PG8_BAR;
  PG8_WAIT_V(4); PG8_BAR;
  PG8_STAGE(PG8_SB(1, 0), cB + kstep, voffB); PG8_STAGE(PG8_SA(1, 0), cA + kstep, voffA); PG8_STAGE(PG8_SB(1, 1), cB + hstepB + kstep, voffB);
  PG8_WAIT_V(6); PG8_BAR;
  for (;;) {
    const bool has_next = S.next(ui + 1, nxt);
    const char* nA = has_next ? (const char*)g.A + (size_t)nxt.pm * tstep : cA; const char* nB = has_next ? (const char*)g.Bt + (size_t)nxt.pn * tstep : cB;
    for (int t = 0; t < nt; t += 2) {
      const bool last = (t == nt - 2);
      const char* a1 = cA + (size_t)(t + 1) * kstep;
      const char* a2 = last ? nA : cA + (size_t)(t + 2) * kstep; const char* b2 = last ? nB : cB + (size_t)(t + 2) * kstep;
      const char* a3 = a2 + kstep; const char* b3 = b2 + kstep;
      PG8_LDB(B0, 0, 0); PG8_SCHED; PG8_LDA(At, 0, 0); PG8_STAGE(PG8_SA(1, 1), a1 + hstep, voffA);
      PG8_WAIT_L(8); PG8_BAR; PG8_WAIT_L(0); PG8_MMA(0, 0, At, B0); PG8_BAR; PG8_SCHED;
      PG8_LDB(B1, 0, 1); PG8_STAGE(PG8_SB(0, 0), b2, voffB);
      PG8_BAR; PG8_WAIT_L(0); PG8_MMA(0, 1, At, B1); PG8_BAR;
      PG8_LDA(At, 0, 1); PG8_STAGE(PG8_SA(0, 0), a2, voffA);
      PG8_BAR; PG8_WAIT_L(0); PG8_MMA(1, 0, At, B0); PG8_BAR; PG8_SCHED;
      PG8_STAGE(PG8_SB(0, 1), b2 + hstepB, voffB);
      PG8_WAIT_V(6); PG8_BAR; PG8_MMA(1, 1, At, B1); PG8_BAR;
      PG8_LDB(B0, 1, 0); PG8_SCHED; PG8_LDA(At, 1, 0); PG8_STAGE(PG8_SA(0, 1), a2 + hstep, voffA);
      PG8_WAIT_L(8); PG8_BAR; PG8_WAIT_L(0); PG8_MMA(0, 0, At, B0); PG8_BAR; PG8_SCHED;
      PG8_LDB(B1, 1, 1); PG8_STAGE(PG8_SB(1, 0), b3, voffB);
      PG8_BAR; PG8_WAIT_L(0); PG8_MMA(0, 1, At, B1); PG8_BAR;
      PG8_LDA(At, 1, 1); PG8_STAGE(PG8_SA(1, 0), a3, voffA);
      PG8_BAR; PG8_WAIT_L(0); PG8_MMA(1, 0, At, B0); PG8_BAR; PG8_SCHED;
      PG8_STAGE(PG8_SB(1, 1), b3 + hstepB, voffB);
      PG8_WAIT_V(6); PG8_BAR; PG8_MMA(1, 1, At, B1); PG8_BAR;
    }
    E(acc, cur, wr, wc, fr, fq);
    if (!has_next) break;
#pragma unroll
    for (int a = 0; a < 2; ++a)
#pragma unroll
      for (int b = 0; b < 2; ++b)
#pragma unroll
        for (int m = 0; m < 4; ++m)
#pragma unroll
          for (int n = 0; n < 2; ++n) acc[a][b][m][n] = (f32x4){0.f, 0.f, 0.f, 0.f};
    cur = nxt; cA = nA; cB = nB; ++ui;
  }
  PG8_WAIT_V(0);
  if (wr == 0) PG8_BAR;
  PG8_BAR;
#undef PG8_SA
#undef PG8_SB
#undef PG8_STAGE
#undef PG8_LDA
#undef PG8_LDB
#undef PG8_MMA
#undef PG8_WAIT_V
#undef PG8_WAIT_L
#undef PG8_BAR
#undef PG8_SCHED
}
}

template <int LAYER>
struct EpiIn {
  Params p; char* xl;
  DEV void operator()(const f32x4 (&acc)[2][2][4][2], const pg8::Unit& u, int wr, int wc, int fr, int fq) const {
    const int lane = fq * 16 + fr;
    const int nb = u.pn * 256 + wc * 64;
    const int region = nb >> 10, f0 = nb & 1023, hc = f0 >> 6;
    char* ws = p.ws;
    u16* vl = (u16*)(xl + (wr * 4 + wc) * 2304);
#pragma unroll
    for (int ai = 0; ai < 2; ++ai) {
      const int tb = u.pm * 256 + ai * 128 + wr * 64;
      if (region <= 1) {
        const float* gn = (region == 0) ? p.q_norm : p.k_norm;
#pragma unroll
        for (int m = 0; m < 4; ++m) {
          const int t = tb + m * 16 + fr;
          const int b = t >> 11, s = t & 2047;
          float rinv = 1.f;
          if (LAYER == 0) {
            float ss = 0.f;
#pragma unroll
            for (int bj = 0; bj < 2; ++bj)
#pragma unroll
              for (int n = 0; n < 2; ++n)
#pragma unroll
                for (int j = 0; j < 4; ++j) ss += acc[ai][bj][m][n][j] * acc[ai][bj][m][n][j];
            ss += __shfl_xor(ss, 16);
            ss += __shfl_xor(ss, 32);
            rinv = rsqrtf(ss * (1.f / 64.f) + 1e-6f);
          }
          u16* fb = (u16*)(ws + (region == 0 ? WS_QF : WS_KF)) + ((size_t)(b * 16 + hc) * 64 + (s >> 5)) * 2048 + ((fq >> 1) * 32 + (s & 31)) * 8 + (fq & 1) * 4;
          float* ko = p.out + (LAYER == 0 ? OFF_K0P : OFF_K1P) + (size_t)t * 1024 + f0 + 4 * fq;
#pragma unroll
          for (int bj = 0; bj < 2; ++bj)
#pragma unroll
            for (int n = 0; n < 2; ++n) {
              f32x4 v = acc[ai][bj][m][n];
              if (LAYER == 0) {
                const f32x4 g4 = *(const f32x4*)(gn + 32 * bj + 16 * n + 4 * fq);
                v = v * g4 * rinv;
              }
              if (region == 1) nt_store_f4(ko + 32 * bj + 16 * n, v);
              if (region == 0) v = v * (0.125f * LOG2E);
              uint2 pk;
              pk.x = pk2(v[0], v[1]);
              pk.y = pk2(v[2], v[3]);
              *(uint2*)(fb + (2 * bj + n) * 512) = pk;
            }
        }
      } else if (region == 2) {
#pragma unroll
        for (int m = 0; m < 4; ++m) {
          float* vo = p.out + (LAYER == 0 ? OFF_V0P : OFF_V1P) + (size_t)(tb + m * 16 + fr) * 1024 + f0 + 4 * fq;
#pragma unroll
          for (int bj = 0; bj < 2; ++bj)
#pragma unroll
            for (int n = 0; n < 2; ++n) nt_store_f4(vo + 32 * bj + 16 * n, acc[ai][bj][m][n]);
        }
        const int r = lane & 31, hh = lane >> 5;
#pragma unroll
        for (int mp = 0; mp < 2; ++mp) {
          const int tk = tb + mp * 32;
          const int b = tk >> 11, tile = (tk & 2047) >> 5;
#pragma unroll
          for (int bj = 0; bj < 2; ++bj) {
#pragma unroll
            for (int mm = 0; mm < 2; ++mm)
#pragma unroll
              for (int n = 0; n < 2; ++n)
#pragma unroll
                for (int j = 0; j < 4; ++j) vl[(16 * n + 4 * fq + j) * 36 + mm * 16 + fr] = f2bf(acc[ai][bj][2 * mp + mm][n][j]);
            u16* vb;
            if (LAYER == 0) vb = (u16*)(ws + WS_VF) + ((size_t)(b * 8 + (f0 >> 7)) * 64 + tile) * 4096 + ((((f0 & 127) >> 5) + bj) * 2) * 512 + lane * 8;
            else            vb = (u16*)(ws + WS_VF) + ((size_t)(b * 16 + hc) * 64 + tile) * 2048 + (bj * 2) * 512 + lane * 8;
#pragma unroll
            for (int sv = 0; sv < 2; ++sv) {
              const uint2 lo = *(const uint2*)(vl + r * 36 + 16 * sv + 4 * hh);
              const uint2 hi = *(const uint2*)(vl + r * 36 + 16 * sv + 8 + 4 * hh);
              *(uint4*)(vb + sv * 512) = make_uint4(lo.x, lo.y, hi.x, hi.y);
            }
          }
        }
      } else {
#pragma unroll
        for (int m = 0; m < 4; ++m) {
          u16* sg = (u16*)(ws + WS_SG) + (size_t)(tb + m * 16 + fr) * 1024 + f0 + 4 * fq;
#pragma unroll
          for (int bj = 0; bj < 2; ++bj)
#pragma unroll
            for (int n = 0; n < 2; ++n) {
              float v[4];
#pragma unroll
              for (int j = 0; j < 4; ++j) { const float x = acc[ai][bj][m][n][j]; v[j] = x * __builtin_amdgcn_rcpf(1.f + __expf(-x)); }
              uint2 pk;
              pk.x = pk2(v[0], v[1]);
              pk.y = pk2(v[2], v[3]);
              *(uint2*)(sg + 32 * bj + 16 * n) = pk;
            }
        }
      }
    }
  }
};

template <int LAYER>
struct EpiOut {
  Params p;
  DEV void operator()(const f32x4 (&acc)[2][2][4][2], const pg8::Unit& u, int wr, int wc, int fr, int fq) const {
    const int col = u.pn * 256 + wc * 64 + 4 * fq;
    const size_t t0 = (size_t)(u.pm * 256 + wr * 64 + fr);
    f32x4 xr[3][4];
    auto rowp = [&](int g) { return (size_t)(t0 + (g >> 2) * 128 + (g & 3) * 16) * 1024 + col; };
    auto ldg = [&](int g, f32x4 (&x)[4]) {
      const float* xi = ((LAYER == 0) ? p.x_prompt : (const float*)p.out) + rowp(g);
#pragma unroll
      for (int q = 0; q < 4; ++q) x[q] = *(const f32x4*)(xi + 32 * (q >> 1) + 16 * (q & 1));
    };
    ldg(0, xr[0]);
    ldg(1, xr[1]);
#pragma unroll
    for (int g = 0; g < 8; ++g) {
      if (g + 2 < 8) ldg(g + 2, xr[(g + 2) % 3]);
      float* yo = p.out + rowp(g);
#pragma unroll
      for (int q = 0; q < 4; ++q) *(f32x4*)(yo + 32 * (q >> 1) + 16 * (q & 1)) = xr[g % 3][q] + acc[g >> 2][q >> 1][g & 3][q & 1];
    }
  }
};

DEV void gemm_tile(const u16* __restrict__ Wt, const u16* __restrict__ X, int n0, int m0, char* lds, f32x4 (&acc)[4][2]) {
  const int tid = opaque_tid(), lane = tid & 63, w = tid >> 6;
  const int wa = w & 1, wb = w >> 1;
  const int lr = lane & 15, lq = lane >> 4;
  const int srow = tid >> 3, skc = (tid & 7) ^ (srow & 7);
  const u16* ga = Wt + (size_t)(n0 + srow) * 1024 + skc * 8;
  const u16* gb = X + (size_t)(m0 + srow) * 1024 + skc * 8;
  typedef __attribute__((address_space(3))) unsigned lds_u32;
  typedef const __attribute__((address_space(1))) unsigned glb_u32;
#define GLDS(gp, lp) __builtin_amdgcn_global_load_lds((glb_u32*)(gp), (lds_u32*)(lp), 16, 0, 0)
#define GT_STAGE(kt) do { char* d_ = sdst + ((kt) & 3) * 32768; const int ko_ = (kt) * 64; \
    GLDS(ga + ko_, d_); GLDS(ga + (size_t)64 * 1024 + ko_, d_ + 8192); \
    GLDS(gb + ko_, d_ + 16384); GLDS(gb + (size_t)64 * 1024 + ko_, d_ + 16384 + 8192); } while (0)
#pragma unroll
  for (int mt = 0; mt < 4; ++mt)
#pragma unroll
    for (int nt = 0; nt < 2; ++nt) acc[mt][nt] = f32x4{0.f, 0.f, 0.f, 0.f};
  char* sdst = lds + tid * 16;
  __syncthreads();
  GT_STAGE(0); GT_STAGE(1); GT_STAGE(2);
  const int aoff = (wa * 64 + lr) * 128;
  const int boff = 16384 + (wb * 32 + lr) * 128;
  const int sw = lr & 7;
  for (int kt = 0; kt < 16; ++kt) {
    if (kt + 2 < 16) asm volatile("s_waitcnt vmcnt(8) lgkmcnt(0)" ::: "memory");
    else if (kt + 1 < 16) asm volatile("s_waitcnt vmcnt(4) lgkmcnt(0)" ::: "memory");
    else asm volatile("s_waitcnt vmcnt(0) lgkmcnt(0)" ::: "memory");
    __builtin_amdgcn_s_barrier();
    asm volatile("" ::: "memory");
    if (kt + 3 < 16) GT_STAGE(kt + 3);
    const char* cur = lds + (kt & 3) * 32768;
#pragma unroll
    for (int kk = 0; kk < 2; ++kk) {
      bf16x8 a[4], b[2];
      const int co = ((kk * 4 + lq) ^ sw) << 4;
#pragma unroll
      for (int mt = 0; mt < 4; ++mt) a[mt] = *(const bf16x8*)(cur + aoff + mt * 2048 + co);
#pragma unroll
      for (int nt = 0; nt < 2; ++nt) b[nt] = *(const bf16x8*)(cur + boff + nt * 2048 + co);
#pragma unroll
      for (int mt = 0; mt < 4; ++mt)
#pragma unroll
        for (int nt = 0; nt < 2; ++nt)
          acc[mt][nt] = __builtin_amdgcn_mfma_f32_16x16x32_bf16(a[mt], b[nt], acc[mt][nt], 0, 0, 0);
    }
  }
  __syncthreads();
#undef GLDS
#undef GT_STAGE
}

template <int LAYER>
DEV void inproj_epilogue(const Params& p, f32x4 (&acc)[4][2], int n0, int m0) {
  const int tid = opaque_tid(), lane = tid & 63, w = tid >> 6;
  const int wa = w & 1, wb = w >> 1;
  const int lr = lane & 15, lq = lane >> 4;
  const int region = n0 >> 10;
  const int f0 = (n0 & 1023) + wa * 64;
  const int hc = f0 >> 6;
  char* ws = p.ws;
#pragma unroll
  for (int nt = 0; nt < 2; ++nt) {
    const int t = m0 + wb * 32 + nt * 16 + lr;
    const bool samp = t >= NTOK_P;
    const int ts = t - NTOK_P;
    const int b = samp ? (ts >> 4) : (t >> 11);
    const int s = samp ? (ts & 15) : (t & 2047);
    if (region <= 1) {
      float rinv = 1.f;
      if (LAYER == 0) {
        float ss = 0.f;
#pragma unroll
        for (int mt = 0; mt < 4; ++mt)
#pragma unroll
          for (int j = 0; j < 4; ++j) ss += acc[mt][nt][j] * acc[mt][nt][j];
        ss += __shfl_xor(ss, 16);
        ss += __shfl_xor(ss, 32);
        rinv = rsqrtf(ss * (1.f / 64.f) + 1e-6f);
      }
      const float qscale = (region == 0) ? (0.125f * LOG2E) : 1.f;
      const float* gn = (region == 0) ? p.q_norm : p.k_norm;
      u16* fb;
      if (region == 0)
        fb = samp ? (u16*)(ws + WS_QFS) + (size_t)(b * 16 + hc) * 2048
                  : (u16*)(ws + WS_QF) + ((size_t)(b * 16 + hc) * 64 + (s >> 5)) * 2048;
      else
        fb = samp ? (u16*)(ws + WS_KFS) + (size_t)(b * 16 + hc) * 2048
                  : (u16*)(ws + WS_KF) + ((size_t)(b * 16 + hc) * 64 + (s >> 5)) * 2048;
      const int rr = samp ? s : (s & 31);
      float* kout = nullptr;
      if (region == 1) {
        if (LAYER == 0) kout = p.out + (samp ? OFF_K0S + (size_t)ts * 1024 : OFF_K0P + (size_t)t * 1024) + f0;
        else            kout = p.out + (samp ? OFF_K1S + (size_t)ts * 1024 : OFF_K1P + (size_t)t * 1024) + f0;
      }
#pragma unroll
      for (int mt = 0; mt < 4; ++mt) {
        float v[4];
        if (LAYER == 0) {
          const float4 g4 = *(const float4*)(gn + mt * 16 + lq * 4);
          v[0] = acc[mt][nt][0] * rinv * g4.x; v[1] = acc[mt][nt][1] * rinv * g4.y;
          v[2] = acc[mt][nt][2] * rinv * g4.z; v[3] = acc[mt][nt][3] * rinv * g4.w;
        } else {
#pragma unroll
          for (int j = 0; j < 4; ++j) v[j] = acc[mt][nt][j];
        }
        if (region == 1) *(float4*)(kout + mt * 16 + lq * 4) = make_float4(v[0], v[1], v[2], v[3]);
        uint2 pk;
        pk.x = pk2(v[0] * qscale, v[1] * qscale);
        pk.y = pk2(v[2] * qscale, v[3] * qscale);
        *(uint2*)(fb + (mt * 64 + (lq >> 1) * 32 + rr) * 8 + (lq & 1) * 4) = pk;
      }
    } else if (region == 2) {
      float* vout;
      if (LAYER == 0) vout = p.out + (samp ? OFF_V0S + (size_t)ts * 1024 : OFF_V0P + (size_t)t * 1024) + f0;
      else            vout = p.out + (samp ? OFF_V1S + (size_t)ts * 1024 : OFF_V1P + (size_t)t * 1024) + f0;
      const int kk = samp ? s : (s & 31);
      const int sv = kk >> 4, hh = (kk >> 2) & 1, jf = ((kk >> 3) & 1) * 4 + (kk & 3);
      u16* vb;
      int dbase;
      if (LAYER == 0) {
        const int h = f0 >> 7;
        dbase = f0 & 127;
        vb = samp ? (u16*)(ws + WS_VFS) + (size_t)(b * 8 + h) * 4096
                  : (u16*)(ws + WS_VF) + ((size_t)(b * 8 + h) * 64 + (s >> 5)) * 4096;
      } else {
        dbase = 0;
        vb = samp ? (u16*)(ws + WS_VFS) + (size_t)(b * 16 + hc) * 2048
                  : (u16*)(ws + WS_VF) + ((size_t)(b * 16 + hc) * 64 + (s >> 5)) * 2048;
      }
#pragma unroll
      for (int mt = 0; mt < 4; ++mt) {
        *(float4*)(vout + mt * 16 + lq * 4) = make_float4(acc[mt][nt][0], acc[mt][nt][1], acc[mt][nt][2], acc[mt][nt][3]);
#pragma unroll
        for (int j = 0; j < 4; ++j) {
          const int d = dbase + mt * 16 + lq * 4 + j;
          vb[((d >> 5) * 2 + sv) * 512 + (hh * 32 + (d & 31)) * 8 + jf] = f2bf(acc[mt][nt][j]);
        }
      }
    } else {
      u16* sg = (u16*)(ws + WS_SG) + (size_t)t * 1024 + f0;
#pragma unroll
      for (int mt = 0; mt < 4; ++mt) {
        float v[4];
#pragma unroll
        for (int j = 0; j < 4; ++j) {
          const float x = acc[mt][nt][j];
          v[j] = x * __builtin_amdgcn_rcpf(1.f + __expf(-x));
        }
        uint2 pk;
        pk.x = pk2(v[0], v[1]);
        pk.y = pk2(v[2], v[3]);
        *(uint2*)(sg + mt * 16 + lq * 4) = pk;
      }
    }
  }
}

template <int LAYER>
DEV void outproj_epilogue(const Params& p, f32x4 (&acc)[4][2], int n0, int m0) {
  const int tid = opaque_tid(), lane = tid & 63, w = tid >> 6;
  const int wa = w & 1, wb = w >> 1;
  const int lr = lane & 15, lq = lane >> 4;
#pragma unroll
  for (int nt = 0; nt < 2; ++nt) {
    const int t = m0 + wb * 32 + nt * 16 + lr;
    float* yo = p.out + (size_t)t * 1024 + n0 + wa * 64 + lq * 4;
    const float* xi;
    if (LAYER == 0)
      xi = (t >= NTOK_P ? p.x_sample + (size_t)(t - NTOK_P) * 1024 : p.x_prompt + (size_t)t * 1024) + n0 + wa * 64 + lq * 4;
    else
      xi = yo;
#pragma unroll
    for (int mt = 0; mt < 4; ++mt) {
      const float4 xv = *(const float4*)(xi + mt * 16);
      *(float4*)(yo + mt * 16) = make_float4(xv.x + acc[mt][nt][0], xv.y + acc[mt][nt][1], xv.z + acc[mt][nt][2], xv.w + acc[mt][nt][3]);
    }
  }
}

DEV void transpose_tile(const float* __restrict__ W, int N, u16* __restrict__ Wt, int k0, int n0, float* ldsf) {
  const int tid = opaque_tid();
#pragma unroll
  for (int i = 0; i < 2; ++i) {
    const int idx = tid + 512 * i;
    const int kr = idx >> 4, c4 = idx & 15;
    const float4 v = *(const float4*)(W + (size_t)(k0 + kr) * N + n0 + c4 * 4);
    float* d = ldsf + kr * 65 + c4 * 4;
    d[0] = v.x; d[1] = v.y; d[2] = v.z; d[3] = v.w;
  }
  __syncthreads();
  {
    const int n = tid >> 3, kc = tid & 7;
    float f[8];
#pragma unroll
    for (int j = 0; j < 8; ++j) f[j] = ldsf[(kc * 8 + j) * 65 + n];
    uint4 o = make_uint4(pk2(f[0], f[1]), pk2(f[2], f[3]), pk2(f[4], f[5]), pk2(f[6], f[7]));
    *(uint4*)(Wt + (size_t)(n0 + n) * 1024 + k0 + kc * 8) = o;
  }
  __syncthreads();
}

template <class SrcOf>
DEV void norm_rows(SrcOf src_of, const float* __restrict__ g, u16* __restrict__ dst, int row0, int stride, int lane) {
  float4 cur[4], nxt[4];
  if (row0 < NTOK) {
    const float4* s = (const float4*)src_of(row0);
#pragma unroll
    for (int i = 0; i < 4; ++i) cur[i] = s[lane + 64 * i];
  }
  for (int row = row0; row < NTOK; row += stride) {
    const int nr = row + stride;
    if (nr < NTOK) {
      const float4* s = (const float4*)src_of(nr);
#pragma unroll
      for (int i = 0; i < 4; ++i) nxt[i] = s[lane + 64 * i];
    }
    float ss = 0.f;
#pragma unroll
    for (int i = 0; i < 4; ++i) ss += cur[i].x * cur[i].x + cur[i].y * cur[i].y + cur[i].z * cur[i].z + cur[i].w * cur[i].w;
    ss = wave_sum(ss);
    const float rn = rsqrtf(ss * (1.f / 1024.f) + 1e-6f);
    uint2* d = (uint2*)(dst + (size_t)row * 1024);
#pragma unroll
    for (int i = 0; i < 4; ++i) {
      const float4 gg = ((const float4*)g)[lane + 64 * i];
      uint2 o;
      o.x = pk2(cur[i].x * rn * gg.x, cur[i].y * rn * gg.y);
      o.y = pk2(cur[i].z * rn * gg.z, cur[i].w * rn * gg.w);
      d[lane + 64 * i] = o;
    }
#pragma unroll
    for (int i = 0; i < 4; ++i) cur[i] = nxt[i];
  }
}

DEV void attn0_ptile(const f32x16& S, float base, float slope2, bool first_half_only, float& l, unsigned (&pw)[8]) {
#pragma unroll
  for (int i = 0; i < 16; i += 2) {
    const float ca = (float)((i & 3) + 8 * (i >> 2));
    const float cb = (float)(((i + 1) & 3) + 8 * ((i + 1) >> 2));
    float ea = ex2(fmaf(-slope2, fabsf(base - ca), S[i]));
    float eb = ex2(fmaf(-slope2, fabsf(base - cb), S[i + 1]));
    if (first_half_only && i >= 8) { ea = 0.f; eb = 0.f; }
    l += ea + eb;
    pw[i >> 1] = pk2(ea, eb);
  }
}

DEV void attn0_gate_load(const Params& p, size_t t, int h, int hh, uint2 (&gt)[4][4]) {
  const u16* sgp = (const u16*)(p.ws + WS_SG) + t * 1024 + h * 128;
#pragma unroll
  for (int db = 0; db < 4; ++db)
#pragma unroll
    for (int g = 0; g < 4; ++g) gt[db][g] = *(const uint2*)(sgp + db * 32 + 8 * g + 4 * hh);
}
DEV void attn0_finish(const Params& p, f32x16 (&O)[4], size_t t, int h, int hh, bool valid, const uint2 (&gtp)[4][4]) {
  float ss = 0.f;
#pragma unroll
  for (int db = 0; db < 4; ++db)
#pragma unroll
    for (int i = 0; i < 16; ++i) ss += O[db][i] * O[db][i];
  ss += __shfl_xor(ss, 32);
  const float rn = rsqrtf(ss * (1.f / 128.f) + 1e-6f) * 0.8f;
  if (valid) {
    u16* ogp = (u16*)(p.ws + WS_ACT) + t * 1024 + h * 128;
#pragma unroll
    for (int db = 0; db < 4; ++db)
#pragma unroll
      for (int g = 0; g < 4; ++g) {
        const int d = db * 32 + 8 * g + 4 * hh;
        const float4 gn = *(const float4*)(p.subln_g + d);
        const uint2 gt = gtp[db][g];
        uint2 o;
        o.x = pk2(O[db][4 * g + 0] * rn * gn.x * bflo(gt.x), O[db][4 * g + 1] * rn * gn.y * bfhi(gt.x));
        o.y = pk2(O[db][4 * g + 2] * rn * gn.z * bflo(gt.y), O[db][4 * g + 3] * rn * gn.w * bfhi(gt.y));
        *(uint2*)(ogp + d) = o;
      }
  }
}

DEV void attn0_finish_coal(const Params& p, f32x16 (&O)[4], size_t t0, int h, int lane_in, char* scr, const uint4 (&gv)[8]) {
  int lane = lane_in;
  asm volatile("" : "+v"(lane));
  const int r = lane & 31, hh = lane >> 5;
  float ss = 0.f;
#pragma unroll
  for (int db = 0; db < 4; ++db)
#pragma unroll
    for (int i = 0; i < 16; ++i) ss += O[db][i] * O[db][i];
  ss += __shfl_xor(ss, 32);
  const float rn = rsqrtf(ss * (1.f / 128.f) + 1e-6f) * 0.8f;
  const int tk = lane >> 4, ck = lane & 15;
#pragma unroll
  for (int q = 0; q < 8; ++q) *(uint4*)(scr + (q * 4 + tk) * 272 + ck * 16) = gv[q];
  asm volatile("s_waitcnt lgkmcnt(0)" ::: "memory");
#pragma unroll
  for (int db = 0; db < 4; ++db)
#pragma unroll
    for (int g = 0; g < 4; ++g) {
      const int d = db * 32 + 8 * g + 4 * hh;
      char* cell = scr + r * 272 + hh * 8 + (db * 32 + 8 * g) * 2;
      const float4 gn = *(const float4*)(p.subln_g + 4 * hh + (db * 32 + 8 * g));
      const uint2 gt = *(const uint2*)cell;
      uint2 o;
      o.x = pk2(O[db][4 * g + 0] * rn * gn.x * bflo(gt.x), O[db][4 * g + 1] * rn * gn.y * bfhi(gt.x));
      o.y = pk2(O[db][4 * g + 2] * rn * gn.z * bflo(gt.y), O[db][4 * g + 3] * rn * gn.w * bfhi(gt.y));
      *(uint2*)cell = o;
    }
  asm volatile("s_waitcnt lgkmcnt(0)" ::: "memory");
  u16* ogp = (u16*)(p.ws + WS_ACT) + t0 * 1024 + h * 128;
#pragma unroll
  for (int q = 0; q < 8; ++q) {
    const uint4 ov = *(const uint4*)(scr + (q * 4 + tk) * 272 + ck * 16);
    *(uint4*)(ogp + (size_t)(q * 4 + tk) * 1024 + ck * 8) = ov;
  }
}

DEV void attn0_prompt(const Params& p, int b, int h, int cp, int kt0, char* lds, int lane_in, int w, float neg_lam) {
  int lane = lane_in;
  asm volatile("" : "+v"(lane));
  const int pair = w >> 1, comp = w & 1;
  const int r = lane & 31, hh = lane >> 5;
  const int qblk = 4 * cp + pair;
  const int my_nt = 2 * ((qblk >> 1) + 1);
  const int NT = 4 * cp + 4;
  char* ws = p.ws;
  typedef __attribute__((address_space(3))) unsigned lds_u32;
  typedef const __attribute__((address_space(1))) unsigned glb_u32;
  char* qst = lds + 65536 + w * 8192 + lane * 16;
  {
    const u16* qb = (const u16*)(ws + WS_QF) + ((size_t)(b * 16 + 2 * h + comp) * 64 + qblk) * 2048 + lane * 8;
#pragma unroll
    for (int s = 0; s < 4; ++s) __builtin_amdgcn_global_load_lds((glb_u32*)(qb + s * 512), (lds_u32*)(qst + s * 1024), 16, 0, 0);
  }
  const u16* src0;
  size_t tstride;
  if (w < 4) { src0 = (const u16*)(ws + WS_KF) + (size_t)(b * 16 + 2 * h + (w >> 1)) * 64 * 2048 + ((2 * w) & 3) * 512 + lane * 8; tstride = 2048; }
  else       { src0 = (const u16*)(ws + WS_VF) + (size_t)(b * 8 + h) * 64 * 4096 + (2 * w - 8) * 512 + lane * 8; tstride = 4096; }
  char* dst0 = lds + (2 * w) * 1024 + lane * 16;
#define ATT_DMA(kt) do { const u16* s_ = src0 + (size_t)(kt) * tstride; char* d_ = dst0 + ((kt) & 3) * 16384; \
    __builtin_amdgcn_global_load_lds((glb_u32*)s_, (lds_u32*)d_, 16, 0, 0); \
    __builtin_amdgcn_global_load_lds((glb_u32*)(s_ + 512), (lds_u32*)(d_ + 1024), 16, 0, 0); } while (0)
  ATT_DMA(kt0); ATT_DMA(kt0 + 1); ATT_DMA(kt0 + 2);
  asm volatile("s_waitcnt vmcnt(6)" ::: "memory");
  bf16x8 qf[4];
#pragma unroll
  for (int s = 0; s < 4; ++s) qf[s] = *(const bf16x8*)(qst + s * 1024);
  f32x16 O[4];
#pragma unroll
  for (int db = 0; db < 4; ++db)
#pragma unroll
    for (int i = 0; i < 16; ++i) O[db][i] = 0.f;
  float l = 0.f;
  const float slope2 = exp2f(-(float)(h + 1)) * LOG2E;
  const float qposf = (float)(qblk * 32 + r);
  for (int kt = kt0; kt < NT; ++kt) {
    if (kt + 2 < NT) asm volatile("s_waitcnt vmcnt(4) lgkmcnt(0)" ::: "memory");
    else if (kt + 1 < NT) asm volatile("s_waitcnt vmcnt(2) lgkmcnt(0)" ::: "memory");
    else asm volatile("s_waitcnt vmcnt(0) lgkmcnt(0)" ::: "memory");
    __builtin_amdgcn_s_barrier();
    asm volatile("" ::: "memory");
    if (kt + 3 < NT) ATT_DMA(kt + 3);
    if (kt < my_nt) {
      const char* img = lds + (kt & 3) * 16384 + lane * 16;
      bf16x8 kf[4], vf[4][2];
#pragma unroll
      for (int s = 0; s < 4; ++s) kf[s] = *(const bf16x8*)(img + (comp * 4 + s) * 1024);
      __builtin_amdgcn_sched_barrier(0);
      f32x16 S;
#pragma unroll
      for (int i = 0; i < 16; ++i) S[i] = 0.f;
#pragma unroll
      for (int s = 0; s < 4; ++s) S = __builtin_amdgcn_mfma_f32_32x32x16_bf16(kf[s], qf[s], S, 0, 0, 0);
      __builtin_amdgcn_sched_barrier(0);
#pragma unroll
      for (int db = 0; db < 4; ++db)
#pragma unroll
        for (int s = 0; s < 2; ++s) vf[db][s] = *(const bf16x8*)(img + (8 + db * 2 + s) * 1024);
      __builtin_amdgcn_sched_barrier(0);
      unsigned pw[8];
      attn0_ptile(S, qposf - (float)(kt * 32 + 4 * hh), slope2, false, l, pw);
#pragma unroll
      for (int s = 0; s < 2; ++s) {
        const bf16x8 pf = mk8(pw[4 * s], pw[4 * s + 1], pw[4 * s + 2], pw[4 * s + 3]);
#pragma unroll
        for (int db = 0; db < 4; ++db) O[db] = __builtin_amdgcn_mfma_f32_32x32x16_bf16(vf[db][s], pf, O[db], 0, 0, 0);
      }
    }
  }
#undef ATT_DMA
  l += __shfl_xor(l, 32);
  float* ldsx = (float*)(lds + 65536 + pair * 16384);
  const size_t t0 = (size_t)b * 2048 + qblk * 32;
  uint4 gv[8];
#pragma unroll
  for (int q = 0; q < 8; ++q) gv[q] = make_uint4(0u, 0u, 0u, 0u);
  if (comp == 0) {
    const u16* sgp = (const u16*)(ws + WS_SG) + t0 * 1024 + h * 128 + (lane & 15) * 8;
#pragma unroll
    for (int q = 0; q < 8; ++q) gv[q] = *(const uint4*)(sgp + (size_t)(q * 4 + (lane >> 4)) * 1024);
  }
  if (comp == 1) {
    const float c2 = neg_lam / l;
#pragma unroll
    for (int db = 0; db < 4; ++db)
#pragma unroll
      for (int i = 0; i < 16; ++i) ldsx[(db * 16 + i) * 64 + lane] = c2 * O[db][i];
  }
  __syncthreads();
  if (comp == 0) {
    const float c1 = 1.f / l;
#pragma unroll
    for (int db = 0; db < 4; ++db)
#pragma unroll
      for (int i = 0; i < 16; ++i) O[db][i] = c1 * O[db][i] + ldsx[(db * 16 + i) * 64 + lane];
    asm volatile("s_waitcnt lgkmcnt(0)" ::: "memory");
    attn0_finish_coal(p, O, t0, h, lane, (char*)ldsx, gv);
  }
}

DEV void attn0_sample(const Params& p, int b, int h, char* lds, int lane_in, int w, float neg_lam) {
  int lane = lane_in;
  asm volatile("" : "+v"(lane));
  const int pair = w >> 1, comp = w & 1;
  const int r = lane & 31, hh = lane >> 5;
  char* ws = p.ws;
  bf16x8 qf[4];
  {
    const u16* qb = (const u16*)(ws + WS_QFS) + (size_t)(b * 16 + 2 * h + comp) * 2048;
#pragma unroll
    for (int s = 0; s < 4; ++s) qf[s] = *(const bf16x8*)(qb + s * 512 + lane * 8);
  }
  const int kt0 = pair * 16, kt1 = kt0 + 16 + (pair == 3 ? 1 : 0);
  const float slope2 = exp2f(-(float)(h + 1)) * LOG2E;
  const float qposf = (float)(2048 + r);
  bf16x8 kf[4], vf[4][2];
  auto load_k = [&](int kt) {
    if (kt < 64) {
      const float* base = p.ck0 + (((size_t)b * 2048 + kt * 32 + r) * 8 + h) * 128 + comp * 64 + 8 * hh;
#pragma unroll
      for (int s = 0; s < 4; ++s) {
        const float4 u0 = *(const float4*)(base + 16 * s);
        const float4 u1 = *(const float4*)(base + 16 * s + 4);
        kf[s] = mk8(pk2(u0.x, u0.y), pk2(u0.z, u0.w), pk2(u1.x, u1.y), pk2(u1.z, u1.w));
      }
    } else {
      const u16* kb = (const u16*)(ws + WS_KFS) + (size_t)(b * 16 + 2 * h + comp) * 2048;
#pragma unroll
      for (int s = 0; s < 4; ++s) kf[s] = *(const bf16x8*)(kb + s * 512 + lane * 8);
    }
  };
  auto load_v = [&](int kt) {
    if (kt < 64) {
      const float* base = p.cv0 + (((size_t)b * 2048 + kt * 32 + 4 * hh) * 8 + h) * 128 + r;
#pragma unroll
      for (int db = 0; db < 4; ++db)
#pragma unroll
        for (int s = 0; s < 2; ++s) {
          float f[8];
#pragma unroll
          for (int j = 0; j < 8; ++j) f[j] = base[(size_t)(16 * s + 8 * (j >> 2) + (j & 3)) * 1024 + db * 32];
          vf[db][s] = mk8(pk2(f[0], f[1]), pk2(f[2], f[3]), pk2(f[4], f[5]), pk2(f[6], f[7]));
        }
    } else {
      const u16* vb = (const u16*)(ws + WS_VFS) + (size_t)(b * 8 + h) * 4096;
#pragma unroll
      for (int db = 0; db < 4; ++db)
#pragma unroll
        for (int s = 0; s < 2; ++s) vf[db][s] = *(const bf16x8*)(vb + (db * 2 + s) * 512 + lane * 8);
    }
  };
  f32x16 O[4];
#pragma unroll
  for (int db = 0; db < 4; ++db)
#pragma unroll
    for (int i = 0; i < 16; ++i) O[db][i] = 0.f;
  float l = 0.f;
  load_k(kt0);
  load_v(kt0);
  for (int kt = kt0; kt < kt1; ++kt) {
    f32x16 S;
#pragma unroll
    for (int i = 0; i < 16; ++i) S[i] = 0.f;
#pragma unroll
    for (int s = 0; s < 4; ++s) S = __builtin_amdgcn_mfma_f32_32x32x16_bf16(kf[s], qf[s], S, 0, 0, 0);
    if (kt + 1 < kt1) load_k(kt + 1);
    unsigned pw[8];
    attn0_ptile(S, qposf - (float)(kt * 32 + 4 * hh), slope2, kt == 64, l, pw);
#pragma unroll
    for (int s = 0; s < 2; ++s) {
      const bf16x8 pf = mk8(pw[4 * s], pw[4 * s + 1], pw[4 * s + 2], pw[4 * s + 3]);
#pragma unroll
      for (int db = 0; db < 4; ++db) O[db] = __builtin_amdgcn_mfma_f32_32x32x16_bf16(vf[db][s], pf, O[db], 0, 0, 0);
    }
    if (kt + 1 < kt1) load_v(kt + 1);
  }
  float* slot = (float*)lds;
  float* lsum = (float*)(lds + 131072);
#pragma unroll
  for (int db = 0; db < 4; ++db)
#pragma unroll
    for (int i = 0; i < 16; ++i) slot[(w * 64 + db * 16 + i) * 64 + lane] = O[db][i];
  lsum[w * 64 + lane] = l;
  __syncthreads();
  if (w == 0) {
    float l1 = 0.f, l2 = 0.f;
#pragma unroll
    for (int q = 0; q < 4; ++q) { l1 += lsum[(2 * q) * 64 + lane]; l2 += lsum[(2 * q + 1) * 64 + lane]; }
    l1 += __shfl_xor(l1, 32);
    l2 += __shfl_xor(l2, 32);
    const float c1 = 1.f / l1, c2 = neg_lam / l2;
#pragma unroll
    for (int db = 0; db < 4; ++db)
#pragma unroll
      for (int i = 0; i < 16; ++i) {
        float o1 = 0.f, o2 = 0.f;
#pragma unroll
        for (int q = 0; q < 4; ++q) {
          o1 += slot[((2 * q) * 64 + db * 16 + i) * 64 + lane];
          o2 += slot[((2 * q + 1) * 64 + db * 16 + i) * 64 + lane];
        }
        O[db][i] = c1 * o1 + c2 * o2;
      }
    uint2 gtp[4][4];
    attn0_gate_load(p, (size_t)(NTOK_P + b * 16 + (r & 15)), h, hh, gtp);
    attn0_finish(p, O, (size_t)(NTOK_P + b * 16 + r), h, hh, r < 16, gtp);
  }
}

template <bool SAMPLE>
DEV void attn1_run(const Params& p, int b, int h, int qblk, int lane, char* scr) {
  const int r = lane & 31, hh = lane >> 5;
  char* ws = p.ws;
  bf16x8 qf[4];
  {
    const u16* qb = SAMPLE ? (const u16*)(ws + WS_QFS) + (size_t)(b * 16 + h) * 2048
                           : (const u16*)(ws + WS_QF) + ((size_t)(b * 16 + h) * 64 + qblk) * 2048;
#pragma unroll
    for (int s = 0; s < 4; ++s) qf[s] = *(const bf16x8*)(qb + s * 512 + lane * 8);
  }
  const u16* kfb = (const u16*)(ws + WS_KF) + (size_t)(b * 16 + h) * 64 * 2048;
  const u16* vfb = (const u16*)(ws + WS_VF) + (size_t)(b * 16 + h) * 64 * 2048;
  const int ntot = SAMPLE ? 65 : (qblk + 1);
  auto load_k = [&](int it, bf16x8 (&kf)[4]) {
    if (SAMPLE && it > 0) {
      const int kt = 64 - it;
      const float* base = p.ck1 + (((size_t)b * 2048 + kt * 32 + r) * 16 + h) * 64 + 8 * hh;
#pragma unroll
      for (int s = 0; s < 4; ++s) {
        const float4 u0 = *(const float4*)(base + 16 * s);
        const float4 u1 = *(const float4*)(base + 16 * s + 4);
        kf[s] = mk8(pk2(u0.x, u0.y), pk2(u0.z, u0.w), pk2(u1.x, u1.y), pk2(u1.z, u1.w));
      }
    } else if (SAMPLE) {
      const u16* kb = (const u16*)(ws + WS_KFS) + (size_t)(b * 16 + h) * 2048;
#pragma unroll
      for (int s = 0; s < 4; ++s) kf[s] = *(const bf16x8*)(kb + s * 512 + lane * 8);
    } else {
      const u16* kb = kfb + (size_t)(qblk - it) * 2048;
#pragma unroll
      for (int s = 0; s < 4; ++s) kf[s] = *(const bf16x8*)(kb + s * 512 + lane * 8);
    }
  };
  auto load_v = [&](int it, bf16x8 (&vf)[2][2]) {
    if (SAMPLE && it > 0) {
      const int kt = 64 - it;
      const float* base = p.cv1 + (((size_t)b * 2048 + kt * 32 + 4 * hh) * 16 + h) * 64 + r;
#pragma unroll
      for (int db = 0; db < 2; ++db)
#pragma unroll
        for (int s = 0; s < 2; ++s) {
          float f[8];
#pragma unroll
          for (int j = 0; j < 8; ++j) f[j] = base[(size_t)(16 * s + 8 * (j >> 2) + (j & 3)) * 1024 + db * 32];
          vf[db][s] = mk8(pk2(f[0], f[1]), pk2(f[2], f[3]), pk2(f[4], f[5]), pk2(f[6], f[7]));
        }
    } else if (SAMPLE) {
      const u16* vb = (const u16*)(ws + WS_VFS) + (size_t)(b * 16 + h) * 2048;
#pragma unroll
      for (int db = 0; db < 2; ++db)
#pragma unroll
        for (int s = 0; s < 2; ++s) vf[db][s] = *(const bf16x8*)(vb + (db * 2 + s) * 512 + lane * 8);
    } else {
      const u16* vb = vfb + (size_t)(qblk - it) * 2048;
#pragma unroll
      for (int db = 0; db < 2; ++db)
#pragma unroll
        for (int s = 0; s < 2; ++s) vf[db][s] = *(const bf16x8*)(vb + (db * 2 + s) * 512 + lane * 8);
    }
  };

  f32x16 O[2];
#pragma unroll
  for (int db = 0; db < 2; ++db)
#pragma unroll
    for (int i = 0; i < 16; ++i) O[db][i] = 0.f;
  float carry = 0.f;
  const bool qvalid = !SAMPLE || r < 16;

  auto process = [&](int it, bf16x8 (&kf)[4], bf16x8 (&vf)[2][2]) -> bool {
    f32x16 S;
#pragma unroll
    for (int i = 0; i < 16; ++i) S[i] = 0.f;
#pragma unroll
    for (int s = 0; s < 4; ++s) S = __builtin_amdgcn_mfma_f32_32x32x16_bf16(kf[s], qf[s], S, 0, 0, 0);
    if (it + 2 < ntot) load_k(it + 2, kf);
    const int thr = (it == 0) ? (r - 4 * hh) : 1000;
    float x[16], lb[16];
#pragma unroll
    for (int i = 0; i < 16; ++i) {
      const int ci = (i & 3) + 8 * (i >> 2);
      const float z2 = S[i];
      const float e = ex2(z2);
      const float L = lg2(1.f + e);
      const bool valid = ci < thr;
      x[i] = valid ? -L : 0.f;
      lb[i] = z2 - L;
    }
    float T[4], Tp[4];
#pragma unroll
    for (int g = 0; g < 4; ++g) {
      T[g] = (x[4 * g] + x[4 * g + 1]) + (x[4 * g + 2] + x[4 * g + 3]);
      Tp[g] = __shfl_xor(T[g], 32);
    }
    float su[4];
    su[3] = 0.f;
    su[2] = T[3] + Tp[3];
    su[1] = su[2] + (T[2] + Tp[2]);
    su[0] = su[1] + (T[1] + Tp[1]);
    const float total = su[0] + (T[0] + Tp[0]);
    unsigned pw[8];
#pragma unroll
    for (int g = 0; g < 4; ++g) {
      const float gs = carry + su[g] + (hh == 0 ? Tp[g] : 0.f);
      const float a3 = gs;
      const float a2 = a3 + x[4 * g + 3];
      const float a1 = a2 + x[4 * g + 2];
      const float a0 = a1 + x[4 * g + 1];
      const int c0 = 8 * g;
      const float w0 = (c0 + 0 < thr) ? ex2(lb[4 * g + 0] + a0) : 0.f;
      const float w1 = (c0 + 1 < thr) ? ex2(lb[4 * g + 1] + a1) : 0.f;
      const float w2 = (c0 + 2 < thr) ? ex2(lb[4 * g + 2] + a2) : 0.f;
      const float w3 = (c0 + 3 < thr) ? ex2(lb[4 * g + 3] + a3) : 0.f;
      pw[2 * g] = pk2(w0, w1);
      pw[2 * g + 1] = pk2(w2, w3);
    }
    carry += total;
#pragma unroll
    for (int s = 0; s < 2; ++s) {
      const bf16x8 pf = mk8(pw[4 * s], pw[4 * s + 1], pw[4 * s + 2], pw[4 * s + 3]);
#pragma unroll
      for (int db = 0; db < 2; ++db) O[db] = __builtin_amdgcn_mfma_f32_32x32x16_bf16(vf[db][s], pf, O[db], 0, 0, 0);
    }
    if (__all((carry < -64.f) || !qvalid)) return true;
    if (it + 2 < ntot) load_v(it + 2, vf);
    return false;
  };

  bf16x8 kA[4], kB[4], vA[2][2], vB[2][2];
  load_k(0, kA);
  load_v(0, vA);
  if (ntot > 1) { load_k(1, kB); load_v(1, vB); }
  for (int it = 0; it < ntot; it += 2) {
    if (process(it, kA, vA)) break;
    if (it + 1 >= ntot) break;
    if (process(it + 1, kB, vB)) break;
  }
  if (!SAMPLE) {
    const size_t t0 = (size_t)b * 2048 + qblk * 32;
    const u16* sgp = (const u16*)(ws + WS_SG) + t0 * 1024 + h * 64;
    u16* ogp = (u16*)(ws + WS_ACT) + t0 * 1024 + h * 64;
    const int tk = lane >> 3, ck = lane & 7;
#pragma unroll
    for (int q = 0; q < 4; ++q) {
      const uint4 gv = *(const uint4*)(sgp + (size_t)(q * 8 + tk) * 1024 + ck * 8);
      *(uint4*)(scr + (q * 8 + tk) * 144 + ck * 16) = gv;
    }
    asm volatile("s_waitcnt lgkmcnt(0)" ::: "memory");
#pragma unroll
    for (int db = 0; db < 2; ++db)
#pragma unroll
      for (int g = 0; g < 4; ++g) {
        char* cell = scr + r * 144 + (db * 32 + 8 * g + 4 * hh) * 2;
        const uint2 gt = *(const uint2*)cell;
        uint2 o;
        o.x = pk2(O[db][4 * g + 0] * bflo(gt.x), O[db][4 * g + 1] * bfhi(gt.x));
        o.y = pk2(O[db][4 * g + 2] * bflo(gt.y), O[db][4 * g + 3] * bfhi(gt.y));
        *(uint2*)cell = o;
      }
    asm volatile("s_waitcnt lgkmcnt(0)" ::: "memory");
#pragma unroll
    for (int q = 0; q < 4; ++q) {
      const uint4 ov = *(const uint4*)(scr + (q * 8 + tk) * 144 + ck * 16);
      *(uint4*)(ogp + (size_t)(q * 8 + tk) * 1024 + ck * 8) = ov;
    }
  } else if (qvalid) {
    const size_t t = (size_t)(NTOK_P + b * 16 + r);
    const u16* sgp = (const u16*)(ws + WS_SG) + t * 1024 + h * 64;
    u16* ogp = (u16*)(ws + WS_ACT) + t * 1024 + h * 64;
#pragma unroll
    for (int db = 0; db < 2; ++db)
#pragma unroll
      for (int g = 0; g < 4; ++g) {
        const int d = db * 32 + 8 * g + 4 * hh;
        const uint2 gt = *(const uint2*)(sgp + d);
        uint2 o;
        o.x = pk2(O[db][4 * g + 0] * bflo(gt.x), O[db][4 * g + 1] * bfhi(gt.x));
        o.y = pk2(O[db][4 * g + 2] * bflo(gt.y), O[db][4 * g + 3] * bfhi(gt.y));
        *(uint2*)(ogp + d) = o;
      }
  }
}

#define XB_TMO      128
#define XB_XCNT(j)  (256  + 64 * (j))
#define XB_XSUB(j)  (1280 + 64 * (j))
#define XB_XGEN(j)  (2304 + 64 * (j))
#define XB_TOP      3328
#define XB_TOPGEN   3392
#define XCD_BAR_WORDS 3456
#define XB_SPIN_CAP (1u << 18)
#define XB_LAS __attribute__((address_space(3)))
DEV unsigned xb_ld(unsigned* p)              { return __hip_atomic_load(p, __ATOMIC_RELAXED, __HIP_MEMORY_SCOPE_AGENT); }
DEV unsigned xb_add(unsigned* p, unsigned v) { return __hip_atomic_fetch_add(p, v, __ATOMIC_RELAXED, __HIP_MEMORY_SCOPE_AGENT); }
DEV unsigned xb_xcc_id() { return (unsigned)__builtin_amdgcn_s_getreg((3 << 11) | 20) & 0xFu; }
#define XB_SPIN(cond, bar) do { unsigned _sp = 0; while (cond) { __builtin_amdgcn_s_sleep(1); \
    if ((++_sp & 255u) == 0u) { if (xb_ld(&(bar)[XB_TMO])) break; if (_sp > XB_SPIN_CAP) { atomicAdd(&(bar)[XB_TMO], 1u); break; } } } } while (0)
struct XcdBarrier { unsigned* bar; unsigned x; volatile XB_LAS unsigned* st; };
DEV XcdBarrier xcd_barrier_post(unsigned* bar, volatile XB_LAS unsigned* st) {
  XcdBarrier b; b.bar = bar; b.x = xb_xcc_id(); b.st = st;
  if (threadIdx.x == 0) (void)xb_add(&bar[XB_XCNT(b.x)], 1u);
  return b;
}
DEV void xcd_barrier_complete(unsigned* bar, unsigned x, unsigned& nloc, unsigned& nx) {
  const unsigned G = gridDim.x * gridDim.y * gridDim.z;
  unsigned sum, cnt, mine, sp = 0u;
  for (;;) {
    sum = 0u; cnt = 0u; mine = 0u;
#pragma unroll
    for (unsigned j = 0; j < 16; ++j) { const unsigned c = xb_ld(&bar[XB_XCNT(j)]); sum += c; cnt += (c > 0u) ? 1u : 0u; mine = (j == x) ? c : mine; }
    if (sum == G) break;
    __builtin_amdgcn_s_sleep(1);
    if ((++sp & 255u) == 0u) { if (xb_ld(&bar[XB_TMO])) break; if (sp > XB_SPIN_CAP) { atomicAdd(&bar[XB_TMO], 1u); break; } }
  }
  nloc = mine > 0u ? mine : 1u; nx = cnt > 0u ? cnt : 1u;
}
DEV void xcd_barrier(const XcdBarrier& b) {
  asm volatile("s_waitcnt vmcnt(0)" ::: "memory");
  __syncthreads();
  if (threadIdx.x == 0) {
    unsigned* bar = b.bar;
    __builtin_amdgcn_s_waitcnt(0);
    unsigned nloc = b.st[0], nx = b.st[1];
    if (nloc == 0u) { xcd_barrier_complete(bar, b.x, nloc, nx); b.st[0] = nloc; b.st[1] = nx; }
    const unsigned old = xb_add(&bar[XB_XSUB(b.x)], 1u);
    const unsigned gen = old / nloc;
    if (old + 1u == (gen + 1u) * nloc) {
      __builtin_amdgcn_fence(__ATOMIC_RELEASE, "agent");
      asm volatile("s_waitcnt vmcnt(0)" ::: "memory");
      const unsigned og = xb_add(&bar[XB_TOP], 1u);
      const unsigned tg = og / nx;
      if (og + 1u == (tg + 1u) * nx) xb_add(&bar[XB_TOPGEN], 1u);
      else XB_SPIN(xb_ld(&bar[XB_TOPGEN]) == tg, bar);
      __builtin_amdgcn_fence(__ATOMIC_ACQUIRE, "agent");
      xb_add(&bar[XB_XGEN(b.x)], 1u);
      asm volatile("s_waitcnt vmcnt(0)" ::: "memory");
    } else {
      XB_SPIN(xb_ld(&bar[XB_XGEN(b.x)]) == gen, bar);
      __builtin_amdgcn_fence(__ATOMIC_ACQUIRE, "agent");
      asm volatile("s_waitcnt vmcnt(0)" ::: "memory");
    }
  }
  __syncthreads();
}

DEV int fetch_unit(unsigned* ctr, int lane) {
  unsigned v = 0;
  if (lane == 0) v = atomicAdd(ctr, 1u);
  return (int)__builtin_amdgcn_readfirstlane(v);
}

__global__ void __launch_bounds__(512, 2) fwd_megakernel(Params p) {
  extern __shared__ __attribute__((aligned(16))) char lds[];
  __shared__ unsigned s_misc[4];
#define s_unit (*(int*)&s_misc[0])
  cg::grid_group grid = cg::this_grid();
#define PHASE_IDS() int tid = threadIdx.x; asm volatile("" : "+v"(tid)); const int lane = tid & 63, w = tid >> 6; const int gw = bid * 8 + w; (void)lane; (void)gw;
  const int nblk = gridDim.x, bid = blockIdx.x;
  const int ngw = nblk * 8;
  char* ws = p.ws;
  unsigned* cnt = (unsigned*)(ws + WS_CNT);
  PG8_LAS unsigned char* ldsg = (PG8_LAS unsigned char*)lds;
  pg8::StaticOrder S;

  if (p.ws == nullptr) grid.sync();
  const XcdBarrier xbar = xcd_barrier_post((unsigned*)(ws + WS_BAR), (volatile XB_LAS unsigned*)&s_misc[1]);

  {
  PHASE_IDS();
  if (tid < 4) s_misc[tid] = 0u;
  {
    uint4* z = (uint4*)(ws + WS_QFS);
    for (int i = bid * 512 + tid; i < 98304; i += nblk * 512) z[i] = make_uint4(0, 0, 0, 0);
  }
  for (int id = bid; id < 2560; id += nblk) {
    if (id < 1024)      transpose_tile(p.w_in0, 4096, (u16*)(ws + WS_WT_IN0), (id >> 6) * 64, (id & 63) * 64, (float*)lds);
    else if (id < 1280) transpose_tile(p.w_out0, 1024, (u16*)(ws + WS_WT_OUT0), ((id - 1024) >> 4) * 64, ((id - 1024) & 15) * 64, (float*)lds);
    else if (id < 2304) transpose_tile(p.w_in1, 4096, (u16*)(ws + WS_WT_IN1), ((id - 1280) >> 6) * 64, ((id - 1280) & 63) * 64, (float*)lds);
    else                transpose_tile(p.w_out1, 1024, (u16*)(ws + WS_WT_OUT1), ((id - 2304) >> 4) * 64, ((id - 2304) & 15) * 64, (float*)lds);
  }
  norm_rows([&](int row) { return row < NTOK_P ? p.x_prompt + (size_t)row * 1024 : p.x_sample + (size_t)(row - NTOK_P) * 1024; },
            p.norm_g0, (u16*)(ws + WS_ACT), gw, ngw, lane);
  }
  xcd_barrier(xbar);

  {
    S.init(NTOK_P, 4096, nblk, bid);
    pg8::Gemm g{(const u16*)(ws + WS_ACT), (const u16*)(ws + WS_WT_IN0), NTOK_P, 4096, 1024};
    EpiIn<0> E{p, lds + pg8::STAGE_BYTES};
    pg8::gemm_phase(ldsg, g, S, E);
    for (int st = bid; st < 32; st += nblk) {
      f32x4 acc[4][2];
      gemm_tile((const u16*)(ws + WS_WT_IN0), (const u16*)(ws + WS_ACT), st * 128, NTOK_P, lds, acc);
      inproj_epilogue<0>(p, acc, st * 128, NTOK_P);
    }
  }
  xcd_barrier(xbar);

  {
    PHASE_IDS();
    float a1 = p.lq1[lane] * p.lk1[lane], a2 = p.lq2[lane] * p.lk2[lane];
    a1 = wave_sum(a1);
    a2 = wave_sum(a2);
    const float lam = __expf(a1) - __expf(a2) + 0.2f;
    const int wu = __builtin_amdgcn_readfirstlane(w);
    float gq = fabsf(p.q_norm[lane]), gk = fabsf(p.k_norm[lane]);
#pragma unroll
    for (int o = 32; o; o >>= 1) { gq = fmaxf(gq, __shfl_xor(gq, o)); gk = fmaxf(gk, __shfl_xor(gk, o)); }
    const float smax2 = 8.f * gq * gk * LOG2E * 1.02f;
    for (;;) {
      __syncthreads();
      if (tid == 0) s_unit = (int)atomicAdd(cnt + 0, 1u);
      __syncthreads();
      const int u = s_unit;
      if (u >= 64 + 2048) break;
      if (u < 64) attn0_sample(p, u >> 3, u & 7, lds, lane, wu, -lam);
      else {
        const int v = u - 64;
        const int hh_ = v & 7, cp_ = 15 - (v >> 7);
        const float dmin = (2.f * smax2 + 75.f) / (exp2f(-(float)(hh_ + 1)) * LOG2E);
        int kt0 = 0;
        if (dmin < 4096.f) {
          const int num = 128 * cp_ - 31 - (int)ceilf(dmin);
          if (num >= 0) kt0 = num / 32 + 1;
        }
        kt0 = __builtin_amdgcn_readfirstlane(kt0);
        attn0_prompt(p, (v & 127) >> 3, hh_, cp_, kt0, lds, lane, wu, -lam);
      }
    }
  }
  xcd_barrier(xbar);

  {
    S.init(NTOK_P, 1024, nblk, bid);
    pg8::Gemm g{(const u16*)(ws + WS_ACT), (const u16*)(ws + WS_WT_OUT0), NTOK_P, 1024, 1024};
    EpiOut<0> E{p};
    pg8::gemm_phase(ldsg, g, S, E);
    for (int st = bid; st < 8; st += nblk) {
      f32x4 acc[4][2];
      gemm_tile((const u16*)(ws + WS_WT_OUT0), (const u16*)(ws + WS_ACT), st * 128, NTOK_P, lds, acc);
      outproj_epilogue<0>(p, acc, st * 128, NTOK_P);
    }
  }
  xcd_barrier(xbar);

  {
    PHASE_IDS();
    norm_rows([&](int row) { return (const float*)(p.out + (size_t)row * 1024); }, p.norm_g1, (u16*)(ws + WS_ACT), gw, ngw, lane);
  }
  xcd_barrier(xbar);

  {
    S.init(NTOK_P, 4096, nblk, bid);
    pg8::Gemm g{(const u16*)(ws + WS_ACT), (const u16*)(ws + WS_WT_IN1), NTOK_P, 4096, 1024};
    EpiIn<1> E{p, lds + pg8::STAGE_BYTES};
    pg8::gemm_phase(ldsg, g, S, E);
    for (int st = bid; st < 32; st += nblk) {
      f32x4 acc[4][2];
      gemm_tile((const u16*)(ws + WS_WT_IN1), (const u16*)(ws + WS_ACT), st * 128, NTOK_P, lds, acc);
      inproj_epilogue<1>(p, acc, st * 128, NTOK_P);
    }
  }
  xcd_barrier(xbar);

  {
  PHASE_IDS();
  for (int u = gw; u < 128 + 16384; u += ngw) {
    if (u < 128) attn1_run<true>(p, u >> 4, u & 15, 0, lane, lds + w * 8192);
    else {
      const int v = u - 128;
      attn1_run<false>(p, (v & 255) >> 4, v & 15, 63 - (v >> 8), lane, lds + w * 8192);
    }
  }
  }
  xcd_barrier(xbar);

  {
    S.init(NTOK_P, 1024, nblk, bid);
    pg8::Gemm g{(const u16*)(ws + WS_ACT), (const u16*)(ws + WS_WT_OUT1), NTOK_P, 1024, 1024};
    EpiOut<1> E{p};
    pg8::gemm_phase(ldsg, g, S, E);
    for (int st = bid; st < 8; st += nblk) {
      f32x4 acc[4][2];
      gemm_tile((const u16*)(ws + WS_WT_OUT1), (const u16*)(ws + WS_ACT), st * 128, NTOK_P, lds, acc);
      outproj_epilogue<1>(p, acc, st * 128, NTOK_P);
    }
  }
}

extern "C" void kernel_launch(void* const* d_in, const int* in_sizes, int n_in, void* d_out, int out_size, void* d_ws,
                              size_t ws_size, hipStream_t stream) {
  Params p{};
  p.x_prompt = (const float*)d_in[0]; p.x_sample = (const float*)d_in[1];
  p.ck0 = (const float*)d_in[2]; p.cv0 = (const float*)d_in[3]; p.ck1 = (const float*)d_in[4]; p.cv1 = (const float*)d_in[5];
  p.norm_g0 = (const float*)d_in[6]; p.w_in0 = (const float*)d_in[7]; p.q_norm = (const float*)d_in[8]; p.k_norm = (const float*)d_in[9];
  p.lq1 = (const float*)d_in[10]; p.lk1 = (const float*)d_in[11]; p.lq2 = (const float*)d_in[12]; p.lk2 = (const float*)d_in[13];
  p.subln_g = (const float*)d_in[14]; p.w_out0 = (const float*)d_in[15]; p.norm_g1 = (const float*)d_in[16];
  p.w_in1 = (const float*)d_in[17]; p.w_out1 = (const float*)d_in[18];
  p.out = (float*)d_out;
  p.ws = (char*)d_ws;
  static int grid_blocks = 0;
  if (!grid_blocks) {
    int dev = 0, cus = 0, per_cu = 0;
    hipGetDevice(&dev);
    hipFuncSetAttribute((const void*)fwd_megakernel, hipFuncAttributeMaxDynamicSharedMemorySize, LDS_BYTES);
    hipDeviceGetAttribute(&cus, hipDeviceAttributeMultiprocessorCount, dev);
    hipOccupancyMaxActiveBlocksPerMultiprocessor(&per_cu, fwd_megakernel, 512, LDS_BYTES);
    if (per_cu < 1) per_cu = 1;
    if (per_cu > 1) per_cu = 1;
    grid_blocks = cus * per_cu;
  }
  hipMemsetAsync((char*)d_ws + WS_CNT, 0, 256 + XCD_BAR_WORDS * 4, stream);
  void* args[] = {&p};
  hipError_t e = hipLaunchCooperativeKernel((void*)fwd_megakernel, dim3(grid_blocks), dim3(512), args, LDS_BYTES, stream);
  if (e != hipSuccess) fprintf(stderr, "cooperative launch failed: %s (grid %d)\n", hipGetErrorString(e), grid_blocks);
}
```
